# Optimizing an MI355X kernel written in HIP

```python
import jax, jax.numpy as jnp
from jax import lax
import numpy as np

D_MODEL = 1024
BATCH = 8
SEQ = 4096
DEPTH = 1

HEAD_DIM = 64
DIL_PAIRS = ((128, 1), (512, 4), (2048, 16))
N_HEADS_DIL = 6
HEADS_PER_DIL = N_HEADS_DIL // len(DIL_PAIRS)
N_HEADS_MOBA = 6
N_HEADS_MEM = 4
MEM_LEN = 256
MOBA_BLOCK = 256
MOBA_TOPK = 3
MOBA_Q_CHUNK = 128
BAND_BLOCK = 128
ROPE_THETA = 500000.0
ROPE_DIM = HEAD_DIM // 4
W_DIL = N_HEADS_DIL * HEAD_DIM
W_MOBA = N_HEADS_MOBA * HEAD_DIM
W_MEM = N_HEADS_MEM * HEAD_DIM
W_DIL_OUT = HEADS_PER_DIL * HEAD_DIM
IN_SPLITS = (W_DIL, 2 * W_DIL, 3 * W_DIL, 3 * W_DIL + W_MOBA, 3 * W_DIL + 2 * W_MOBA, 3 * W_DIL + 3 * W_MOBA)
W_IN = 3 * W_DIL + 3 * W_MOBA + W_MEM
N_BRANCH = 3
N_EXPERTS = 256
N_EXPERT_GROUPS = 8
TOPK_GROUPS = 4
TOP_K = 8
D_EXPERT = 256
D_SHARED = 256
ROUTED_SCALE = 2.5
EXPERT_BLOCK = 128
LN_EPS = 1e-5
ALPHA = (2.0 * DEPTH) ** 0.25
BETA = (8.0 * DEPTH) ** -0.25

kernel_name = 'hybrid_dilated_moba_memory_moe_deepnorm'


def layer_norm(x, g, b):
    xf = x.astype(jnp.float32)
    mu = jnp.mean(xf, -1, keepdims=True)
    var = jnp.mean(jnp.square(xf - mu), -1, keepdims=True)
    return ((xf - mu) * lax.rsqrt(var + LN_EPS) * g + b).astype(x.dtype)


def partial_rope(t, positions):
    half = ROPE_DIM // 2
    inv_freq = ROPE_THETA ** (-jnp.arange(half, dtype=jnp.float32) / half)
    ang = positions.astype(jnp.float32)[:, :, None] * inv_freq
    cos = jnp.cos(ang)[:, :, None, :]
    sin = jnp.sin(ang)[:, :, None, :]
    r1 = t[..., :half].astype(jnp.float32)
    r2 = t[..., half:ROPE_DIM].astype(jnp.float32)
    rot = jnp.concatenate([r1 * cos - r2 * sin, r2 * cos + r1 * sin], -1).astype(t.dtype)
    return jnp.concatenate([rot, t[..., ROPE_DIM:]], -1)


def dilated_group_attention(q, k, v, window, dilation):
    B, S, H, Dh = q.shape
    L = S // dilation
    span = window // dilation
    assert span <= BAND_BLOCK
    nblk = -(-L // BAND_BLOCK)
    Lp = nblk * BAND_BLOCK

    def strided(t):
        t = t.reshape(B, L, dilation, H, Dh).transpose(0, 2, 3, 1, 4)
        t = jnp.pad(t, ((0, 0), (0, 0), (0, 0), (0, Lp - L), (0, 0)))
        return t.reshape(B, dilation, H, nblk, BAND_BLOCK, Dh)

    qs, ks, vs = strided(q), strided(k), strided(v)

    def with_prev(t):
        prev = jnp.pad(t, ((0, 0), (0, 0), (0, 0), (1, 0), (0, 0), (0, 0)))[:, :, :, :-1]
        return jnp.concatenate([prev, t], axis=4)

    kb, vb = with_prev(ks), with_prev(vs)
    qi = jnp.arange(BAND_BLOCK)[:, None]
    kj = jnp.arange(2 * BAND_BLOCK)[None, :]
    dist = qi + BAND_BLOCK - kj
    blk = jnp.arange(nblk)[:, None, None]
    allowed = (dist >= 0) & (dist <= span) & (blk * BAND_BLOCK + kj - BAND_BLOCK >= 0)
    s = jnp.einsum('bdhnqc,bdhnkc->bdhnqk', qs, kb).astype(jnp.float32) * (Dh ** -0.5)
    s = jnp.where(allowed, s, -jnp.inf)
    lse = jax.nn.logsumexp(s, axis=-1)
    p = jnp.exp(s - lse[..., None]).astype(v.dtype)
    o = jnp.einsum('bdhnqk,bdhnkc->bdhnqc', p, vb)
    o = o.reshape(B, dilation, H, Lp, Dh)[:, :, :, :L].transpose(0, 3, 1, 2, 4).reshape(B, S, H, Dh)
    lse = lse.reshape(B, dilation, H, Lp)[..., :L].transpose(0, 3, 1, 2).reshape(B, S, H)
    return o, lse


def moba_attention(q, k, v):
    B, S, H, Dh = q.shape
    nb = -(-S // MOBA_BLOCK)
    sp = nb * MOBA_BLOCK
    nc = sp // MOBA_Q_CHUNK
    k_sel = min(MOBA_TOPK, nb)
    padw = ((0, 0), (0, sp - S), (0, 0), (0, 0))
    qp, kp, vp = jnp.pad(q, padw), jnp.pad(k, padw), jnp.pad(v, padw)
    kb = kp.reshape(B, nb, MOBA_BLOCK, H, Dh).transpose(0, 3, 1, 2, 4)
    vb = vp.reshape(B, nb, MOBA_BLOCK, H, Dh).transpose(0, 3, 1, 2, 4)
    kmean = jnp.mean(kb.astype(jnp.float32), axis=3)
    gate = jnp.einsum('bshc,bhnc->bhsn', qp.astype(jnp.float32), kmean)
    q_blk = jnp.arange(sp) // MOBA_BLOCK
    past = jnp.arange(nb)[None, :] < q_blk[:, None]
    gate = jnp.where(past, gate, -jnp.inf)
    _, sel = lax.top_k(gate, k_sel)
    qc = qp.reshape(B, nc, MOBA_Q_CHUNK, H, Dh).transpose(0, 1, 3, 2, 4).reshape(B * nc, H, MOBA_Q_CHUNK, Dh)
    selc = sel.reshape(B, H, nc, MOBA_Q_CHUNK, k_sel).transpose(0, 2, 1, 3, 4).reshape(B * nc, H, MOBA_Q_CHUNK, k_sel)
    flat_ids = jnp.arange(B * nc)
    b_ids = flat_ids // nc
    c_ids = flat_ids % nc
    scale = Dh ** -0.5
    h_ar = jnp.arange(H)[:, None, None]

    def chunk(args):
        qch, sch, b, c = args
        kbb, vbb = kb[b], vb[b]
        own = (c * MOBA_Q_CHUNK) // MOBA_BLOCK
        qpos = c * MOBA_Q_CHUNK + jnp.arange(MOBA_Q_CHUNK)
        ks, vs = kbb[h_ar, sch], vbb[h_ar, sch]
        k_own = lax.dynamic_index_in_dim(kbb, own, axis=1, keepdims=False)
        v_own = lax.dynamic_index_in_dim(vbb, own, axis=1, keepdims=False)
        s_sel = jnp.einsum('hqc,hqnkc->hqnk', qch, ks).astype(jnp.float32) * scale
        s_sel = jnp.where((jnp.arange(k_sel) < own)[None, None, :, None], s_sel, -jnp.inf)
        s_own = jnp.einsum('hqc,hkc->hqk', qch, k_own).astype(jnp.float32) * scale
        kpos = own * MOBA_BLOCK + jnp.arange(MOBA_BLOCK)
        s_own = jnp.where((kpos[None, :] <= qpos[:, None])[None], s_own, -jnp.inf)
        s_all = jnp.concatenate([s_sel.reshape(H, MOBA_Q_CHUNK, k_sel * MOBA_BLOCK), s_own], -1)
        p = jax.nn.softmax(s_all, axis=-1).astype(v.dtype)
        p_sel = p[..., :k_sel * MOBA_BLOCK].reshape(H, MOBA_Q_CHUNK, k_sel, MOBA_BLOCK)
        p_own = p[..., k_sel * MOBA_BLOCK:]
        return jnp.einsum('hqnk,hqnkc->hqc', p_sel, vs) + jnp.einsum('hqk,hkc->hqc', p_own, v_own)

    out = lax.map(chunk, (qc, selc, b_ids, c_ids))
    out = out.reshape(B, nc, H, MOBA_Q_CHUNK, Dh).transpose(0, 1, 3, 2, 4).reshape(B, sp, H * Dh)
    return out[:, :S]


def memory_cross_attention(q, mem, w_mem_kv):
    B, S, H, Dh = q.shape
    kv = (mem @ w_mem_kv).reshape(B, mem.shape[1], 2, H, Dh)
    k, v = kv[:, :, 0], kv[:, :, 1]
    s = jnp.einsum('bshc,bmhc->bhsm', q, k).astype(jnp.float32) * (Dh ** -0.5)
    p = jax.nn.softmax(s, axis=-1).astype(v.dtype)
    return jnp.einsum('bhsm,bmhc->bshc', p, v).reshape(B, S, H * Dh)


def moe_ffn(h, w_router, router_bias, w_e_gate, w_e_up, w_e_down, w_s_gate, w_s_up, w_s_down):
    B, S, D = h.shape
    N = B * S
    xt = h.reshape(N, D)
    scores = jax.nn.sigmoid((xt @ w_router).astype(jnp.float32))
    biased = scores + router_bias.astype(jnp.float32)
    grouped = biased.reshape(N, N_EXPERT_GROUPS, N_EXPERTS // N_EXPERT_GROUPS)
    group_score = jnp.sum(lax.top_k(grouped, 2)[0], axis=-1)
    _, top_groups = lax.top_k(group_score, TOPK_GROUPS)
    keep = jnp.any(top_groups[:, :, None] == jnp.arange(N_EXPERT_GROUPS)[None, None, :], axis=1)
    masked = jnp.where(keep[:, :, None], grouped, -jnp.inf).reshape(N, N_EXPERTS)
    _, eidx = lax.top_k(masked, TOP_K)
    gw = jnp.take_along_axis(scores, eidx, axis=-1)
    gw = gw / jnp.sum(gw, -1, keepdims=True) * ROUTED_SCALE
    A = N * TOP_K
    e_flat = eidx.reshape(A)
    tok_flat = jnp.arange(A, dtype=jnp.int32) // TOP_K
    w_flat = gw.reshape(A)
    order = jnp.argsort(e_flat)
    e_sorted = e_flat[order]
    counts = jnp.bincount(e_flat, length=N_EXPERTS)
    padded = (counts + EXPERT_BLOCK - 1) // EXPERT_BLOCK * EXPERT_BLOCK
    pad_end = jnp.cumsum(padded)
    pad_start = pad_end - padded
    start = jnp.cumsum(counts) - counts
    dest = pad_start[e_sorted] + jnp.arange(A) - start[e_sorted]
    R = A + N_EXPERTS * EXPERT_BLOCK
    nblk = R // EXPERT_BLOCK
    row_tok = jnp.zeros((R,), jnp.int32).at[dest].set(tok_flat[order])
    row_w = jnp.zeros((R,), jnp.float32).at[dest].set(w_flat[order])
    blk_e = jnp.minimum(jnp.searchsorted(pad_end, jnp.arange(nblk) * EXPERT_BLOCK, side='right'), N_EXPERTS - 1)

    def body(acc, blk):
        e, toks, ws = blk
        xb = xt[toks]
        hid = jax.nn.silu(xb @ w_e_gate[e]) * (xb @ w_e_up[e])
        yb = (hid @ w_e_down[e]) * ws[:, None].astype(xb.dtype)
        return acc.at[toks].add(yb.astype(acc.dtype)), None

    routed, _ = lax.scan(body, jnp.zeros((N, D), xt.dtype),
                         (blk_e, row_tok.reshape(nblk, EXPERT_BLOCK), row_w.reshape(nblk, EXPERT_BLOCK)))
    shared = (jax.nn.silu(xt @ w_s_gate) * (xt @ w_s_up)) @ w_s_down
    return (routed + shared).reshape(B, S, D)


def hybrid_layer(x, mem, positions, w_in, w_mem_kv, w_gate, b_gate, w_br_dil, w_br_moba, w_br_mem,
                 w_out, ln1_g, ln1_b, w_router, router_bias, w_e_gate, w_e_up, w_e_down,
                 w_s_gate, w_s_up, w_s_down, ln2_g, ln2_b):
    B, S, D = x.shape
    parts = jnp.split(x @ w_in, IN_SPLITS, axis=-1)
    q_d, k_d, v_d, q_m, k_m, v_m, q_x = [t.reshape(B, S, -1, HEAD_DIM) for t in parts]
    q_d, k_d = partial_rope(q_d, positions), partial_rope(k_d, positions)
    q_m, k_m = partial_rope(q_m, positions), partial_rope(k_m, positions)
    outs, lses = [], []
    for g, (window, dilation) in enumerate(DIL_PAIRS):
        hs = slice(g * HEADS_PER_DIL, (g + 1) * HEADS_PER_DIL)
        o, l = dilated_group_attention(q_d[:, :, hs], k_d[:, :, hs], v_d[:, :, hs], window, dilation)
        outs.append(o)
        lses.append(l)
    wts = jax.nn.softmax(jnp.stack(lses, axis=2), axis=2).astype(x.dtype)
    y_dil = jnp.sum(wts[..., None] * jnp.stack(outs, axis=2), axis=2).reshape(B, S, W_DIL_OUT)
    y_moba = moba_attention(q_m, k_m, v_m)
    y_mem = memory_cross_attention(q_x, mem, w_mem_kv)
    gates = jax.nn.sigmoid((x @ w_gate + b_gate).astype(jnp.float32)).astype(x.dtype).reshape(B, S, N_BRANCH, D)
    merged = (gates[:, :, 0] * (y_dil @ w_br_dil) + gates[:, :, 1] * (y_moba @ w_br_moba)
              + gates[:, :, 2] * (y_mem @ w_br_mem))
    x = layer_norm(ALPHA * x + merged @ w_out, ln1_g, ln1_b)
    x = layer_norm(ALPHA * x + moe_ffn(x, w_router, router_bias, w_e_gate, w_e_up, w_e_down,
                                       w_s_gate, w_s_up, w_s_down), ln2_g, ln2_b)
    return x


def setup_inputs(seed: int = 0) -> dict:
    key = jax.random.key(seed)
    ks = jax.random.split(key, 24)
    D = D_MODEL
    L = DEPTH

    def nrm(k, shape, scale):
        return jax.random.normal(k, shape, jnp.float32) * scale

    x = nrm(ks[0], (BATCH, SEQ, D), 1.0)
    mem = nrm(ks[1], (BATCH, MEM_LEN, D), 1.0)
    offset = jax.random.randint(ks[2], (BATCH, 1), 0, 1024, dtype=jnp.int32)
    positions = jnp.arange(SEQ, dtype=jnp.int32)[None, :] + offset
    return {
        'x': x,
        'mem': mem,
        'positions': positions,
        'w_in': nrm(ks[3], (L, D, W_IN), D ** -0.5),
        'w_mem_kv': nrm(ks[4], (L, D, 2 * W_MEM), D ** -0.5),
        'w_gate': nrm(ks[5], (L, D, N_BRANCH * D), D ** -0.5),
        'b_gate': nrm(ks[6], (L, N_BRANCH * D), 0.01),
        'w_br_dil': nrm(ks[7], (L, W_DIL_OUT, D), W_DIL_OUT ** -0.5),
        'w_br_moba': nrm(ks[8], (L, W_MOBA, D), W_MOBA ** -0.5),
        'w_br_mem': nrm(ks[9], (L, W_MEM, D), W_MEM ** -0.5),
        'w_out': nrm(ks[10], (L, D, D), BETA * D ** -0.5),
        'ln1_g': 1.0 + nrm(ks[11], (L, D), 0.02),
        'ln1_b': nrm(ks[12], (L, D), 0.02),
        'w_router': nrm(ks[13], (L, D, N_EXPERTS), D ** -0.5),
        'router_bias': nrm(ks[14], (L, N_EXPERTS), 0.01),
        'w_e_gate': nrm(ks[15], (L, N_EXPERTS, D, D_EXPERT), D ** -0.5),
        'w_e_up': nrm(ks[16], (L, N_EXPERTS, D, D_EXPERT), D ** -0.5),
        'w_e_down': nrm(ks[17], (L, N_EXPERTS, D_EXPERT, D), BETA * D_EXPERT ** -0.5),
        'w_s_gate': nrm(ks[18], (L, D, D_SHARED), D ** -0.5),
        'w_s_up': nrm(ks[19], (L, D, D_SHARED), D ** -0.5),
        'w_s_down': nrm(ks[20], (L, D_SHARED, D), BETA * D_SHARED ** -0.5),
        'ln2_g': 1.0 + nrm(ks[21], (L, D), 0.02),
        'ln2_b': nrm(ks[22], (L, D), 0.02),
    }


def reference(x, mem, positions, w_in, w_mem_kv, w_gate, b_gate, w_br_dil, w_br_moba, w_br_mem,
              w_out, ln1_g, ln1_b, w_router, router_bias, w_e_gate, w_e_up, w_e_down,
              w_s_gate, w_s_up, w_s_down, ln2_g, ln2_b):
    for l in range(DEPTH):
        x = hybrid_layer(x, mem, positions, w_in[l], w_mem_kv[l], w_gate[l], b_gate[l], w_br_dil[l],
                         w_br_moba[l], w_br_mem[l], w_out[l], ln1_g[l], ln1_b[l], w_router[l],
                         router_bias[l], w_e_gate[l], w_e_up[l], w_e_down[l], w_s_gate[l],
                         w_s_up[l], w_s_down[l], ln2_g[l], ln2_b[l])
    return x
```

```cpp
#include <hip/hip_runtime.h>
#include <hip/hip_cooperative_groups.h>
#include <cstdint>
#include <cstdio>
namespace cg = cooperative_groups;

#define LAS __attribute__((address_space(3)))
typedef unsigned short bf16_t;
typedef short bf16x8 __attribute__((ext_vector_type(8)));
typedef short s16x4 __attribute__((ext_vector_type(4)));
typedef float f32x2 __attribute__((ext_vector_type(2)));
typedef float f32x4 __attribute__((ext_vector_type(4)));
typedef float f32x16 __attribute__((ext_vector_type(16)));
typedef unsigned u32x2 __attribute__((ext_vector_type(2)));
typedef unsigned u32x4 __attribute__((ext_vector_type(4)));
typedef __bf16 bf16x2_t __attribute__((ext_vector_type(2)));

constexpr int NTOK = 32768, DM = 1024, NBATCH = 8, SEQ = 4096;
constexpr int WIN = 2560, NGATE = 3072, NQG = WIN + NGATE;
constexpr int NEXP = 256, TOPK = 8;
constexpr int NASSIGN = NTOK * TOPK;
constexpr int MAXROWS = NASSIGN + NEXP * 256;
constexpr float ALPHA = 1.189207115002721f;
constexpr float C2 = 0.18033688011112042f;
constexpr float LN_EPS = 1e-5f;
constexpr float LOG2E = 1.4426950408889634f;
constexpr float NEG_INF = -__builtin_inff();

constexpr size_t MiB = (size_t)1 << 20;
constexpr size_t WS_W2T = 0;
constexpr size_t WS_X1F = 128 * MiB;
constexpr size_t WS_HIDS = 256 * MiB;
constexpr size_t WS_CTL = 272 * MiB;
constexpr size_t WS_WTQG = 273 * MiB;
constexpr size_t WS_WTKV = 284 * MiB;
constexpr size_t WS_WTBRD = 285 * MiB;
constexpr size_t WS_WTBRM = 285 * MiB + 256 * 1024;
constexpr size_t WS_WTBRX = 286 * MiB;
constexpr size_t WS_WTOUT = 287 * MiB;
constexpr size_t WS_WTRS = 289 * MiB;
constexpr size_t WS_WTSD = 291 * MiB;
constexpr size_t WS_ROPE = 292 * MiB;
constexpr size_t WS_KVM = 294 * MiB;
constexpr size_t WS_LSE = 296 * MiB;
constexpr size_t WS_EIDX = 297 * MiB;
constexpr size_t WS_GWT = 298 * MiB;
constexpr size_t WS_POS = 299 * MiB;
constexpr size_t WS_ROWTOK = 300 * MiB;
constexpr size_t WS_ROWW = 301 * MiB + 256 * 1024;
constexpr size_t WS_ROWY = 302 * MiB + 512 * 1024;
constexpr size_t WS_W1T = 304 * MiB;
constexpr size_t WS_XB = 560 * MiB;
constexpr size_t WS_ODIL = 560 * MiB;
constexpr size_t WS_YMOBA = 584 * MiB;
constexpr size_t WS_YMEM = 608 * MiB;
constexpr size_t WS_X1B = 560 * MiB;
constexpr size_t WS_QKV = 624 * MiB;
constexpr size_t WS_MERGED = 624 * MiB;
constexpr size_t WS_YDIL = 688 * MiB;
constexpr size_t WS_SCORES = 624 * MiB;
constexpr size_t WS_HID = 624 * MiB;
constexpr size_t WS_GATES = 784 * MiB;
constexpr size_t WS_MEMB = 976 * MiB;
constexpr size_t WS_Y1 = 304 * MiB;
constexpr size_t WS_Y2 = 784 * MiB;
constexpr int Y_SPLIT = 163840;
constexpr size_t WS_END = 980 * MiB;
constexpr int CW_COUNT = 0;
constexpr int CW_QUEUE = 512;
constexpr int CW_RT = 520;
constexpr int CW_TILEE = 1024;
constexpr int CW_KSUM = 8192;

__device__ __forceinline__ unsigned cvtpk(float lo, float hi) { f32x2 v = {lo, hi}; bf16x2_t b = __builtin_convertvector(v, bf16x2_t); return __builtin_bit_cast(unsigned, b); }
__device__ __forceinline__ float bflo(unsigned w) { return __uint_as_float(w << 16); }
__device__ __forceinline__ float bfhi(unsigned w) { return __uint_as_float(w & 0xffff0000u); }
__device__ __forceinline__ float fast_sigmoid(float x) { return __builtin_amdgcn_rcpf(1.0f + __builtin_amdgcn_exp2f(-x * LOG2E)); }
__device__ __forceinline__ float wave_sum(float v) {
#pragma unroll
    for (int o = 1; o < 64; o <<= 1) v += __shfl_xor(v, o);
    return v;
}
__device__ __forceinline__ u32x4 pack8(f32x4 a, f32x4 b) { u32x4 w; w.x = cvtpk(a[0], a[1]); w.y = cvtpk(a[2], a[3]); w.z = cvtpk(b[0], b[1]); w.w = cvtpk(b[2], b[3]); return w; }
__device__ __forceinline__ void unpack8(u32x4 w, f32x4& a, f32x4& b) { a = (f32x4){bflo(w.x), bfhi(w.x), bflo(w.y), bfhi(w.y)}; b = (f32x4){bflo(w.z), bfhi(w.z), bflo(w.w), bfhi(w.w)}; }
#define LDS_WAIT() asm volatile("s_waitcnt lgkmcnt(0)" ::: "memory")
#define VM_WAIT() asm volatile("s_waitcnt vmcnt(0)" ::: "memory")

namespace pg8 {
constexpr int BM = 256, BK = 64, HALF = 128, HTB = HALF * BK * 2, STAGE_BYTES = 8 * HTB;
__device__ __forceinline__ int lds_byte(int r, int c) { const int st = (r >> 4) * 2 + (c >> 5), rr = r & 15, cc = c & 31, ob = rr * 64 + cc * 2; return st * 1024 + (ob ^ (((ob >> 9) & 1) << 5)); }
__device__ __forceinline__ void stage_rc(int b, int& R, int& C) { const int st = b / 1024, sb = b % 1024, swz = sb ^ (((sb >> 9) & 1) << 5); R = (st >> 1) * 16 + swz / 64; C = (st & 1) * 32 + (swz % 64) / 2; }
__device__ __forceinline__ int perm32(int rho) { const int n = rho >> 4, i = rho & 15; return 8 * (i >> 2) + 4 * n + (i & 3); }
__device__ __forceinline__ int xcd_remap(int L, int nwg) { const int q = nwg / 8, r = nwg % 8, xcd = L % 8, off = L / 8; return (xcd < r ? xcd * (q + 1) : r * (q + 1) + (xcd - r) * q) + off; }

struct GUnit {
    const char* a; const char* b;
    int nt;
    int pm, pn, kind, aux;
    int hsA, hsB;
    unsigned offA[2], offB[2];
    unsigned offA1[2];
};
struct LaneGeom {
    int R[2], C[2], Rp[2];
    __device__ __forceinline__ void init(int tid) {
#pragma unroll
        for (int i = 0; i < 2; ++i) { stage_rc(tid * 16 + i * 8192, R[i], C[i]); Rp[i] = (R[i] & ~31) + perm32(R[i] & 31); }
    }
};
template <class Epi, class Sched, bool ALIGN_EPI>
__device__ __forceinline__ void gemm_phase(LAS unsigned char* lds, const Sched& S, const Epi& E) {
    const int tid = threadIdx.x, wid = __builtin_amdgcn_readfirstlane(tid >> 6), lane = tid & 63, wr = wid >> 2, wc = wid & 3, fr = lane & 15, fq = lane >> 4;
    const unsigned ldsw = (unsigned)wid * 1024u;
    const int aoff = lds_byte(wr * 64 + fr, fq * 8), boff = lds_byte(wc * 32 + fr, fq * 8);
#define PG8_SA(b, h) (((b) * 2 + (h)) * HTB)
#define PG8_SB(b, h) ((4 + (b) * 2 + (h)) * HTB)
#define PG8_STAGE(bufoff, gbase, voff) do { _Pragma("unroll") for (int _i = 0; _i < 2; ++_i) \
        __builtin_amdgcn_global_load_lds((const unsigned*)((const char*)(gbase) + (voff)[_i]), (LAS unsigned*)(lds + (bufoff) + ldsw + _i * 8192), 16, 0, 0); } while (0)
#define PG8_LDA(dst, b, h) do { _Pragma("unroll") for (int m = 0; m < 4; ++m) _Pragma("unroll") for (int k = 0; k < 2; ++k) dst[m][k] = *(const LAS bf16x8*)(lds + PG8_SA(b, h) + aoff + m * 2048 + k * 1024); } while (0)
#define PG8_LDB(dst, b, h) do { _Pragma("unroll") for (int n = 0; n < 2; ++n) _Pragma("unroll") for (int k = 0; k < 2; ++k) dst[n][k] = *(const LAS bf16x8*)(lds + PG8_SB(b, h) + boff + n * 2048 + k * 1024); } while (0)
#define PG8_MMA(ai, bj, At, Bt) do { __builtin_amdgcn_s_setprio(1); _Pragma("unroll") for (int m = 0; m < 4; ++m) _Pragma("unroll") for (int n = 0; n < 2; ++n) _Pragma("unroll") for (int k = 0; k < 2; ++k) \
        acc[ai][bj][m][n] = __builtin_amdgcn_mfma_f32_16x16x32_bf16(Bt[n][k], At[m][k], acc[ai][bj][m][n], 0, 0, 0); __builtin_amdgcn_s_setprio(0); } while (0)
#define PG8_WAIT_V(n) asm volatile("s_waitcnt vmcnt(" #n ")" ::: "memory")
#define PG8_WAIT_L(n) asm volatile("s_waitcnt lgkmcnt(" #n ")" ::: "memory")
#define PG8_BAR __builtin_amdgcn_s_barrier()
#define PG8_SCHED __builtin_amdgcn_sched_barrier(0)
    GUnit cur, nxt; int ui = 0;
    if (!S.next(0, cur)) return;
    f32x4 acc[2][2][4][2];
#pragma unroll
    for (int a = 0; a < 2; ++a)
#pragma unroll
        for (int b = 0; b < 2; ++b)
#pragma unroll
            for (int m = 0; m < 4; ++m)
#pragma unroll
                for (int n = 0; n < 2; ++n) acc[a][b][m][n] = (f32x4){0.f, 0.f, 0.f, 0.f};
    bf16x8 At[4][2], B0[2][2], B1[2][2];
    constexpr bool GA = Sched::GATHER;
#define PG8_STA(bufoff, U, h, koff) do { if constexpr (GA) { if ((h) == 0) PG8_STAGE(bufoff, (U).a + (koff), (U).offA); else PG8_STAGE(bufoff, (U).a + (koff), (U).offA1); } \
        else PG8_STAGE(bufoff, (U).a + (koff) + (size_t)((h) * (U).hsA), (U).offA); } while (0)
#define PG8_STB(bufoff, U, h, koff) PG8_STAGE(bufoff, (U).b + (koff) + (size_t)((h) * (U).hsB), (U).offB)
    PG8_STB(PG8_SB(0, 0), cur, 0, 0); PG8_STB(PG8_SB(0, 1), cur, 1, 0); PG8_STA(PG8_SA(0, 0), cur, 0, 0); PG8_STA(PG8_SA(0, 1), cur, 1, 0);
    if (wr == 1) PG8_BAR;
    PG8_WAIT_V(2); PG8_BAR;
    PG8_STB(PG8_SB(1, 0), cur, 0, 128); PG8_STA(PG8_SA(1, 0), cur, 0, 128); PG8_STB(PG8_SB(1, 1), cur, 1, 128);
    PG8_WAIT_V(6); PG8_BAR;
    for (;;) {
        const bool has_next = S.next(ui + 1, nxt);
        if (!has_next) nxt = cur;
        const int nt = cur.nt;
        for (int t = 0; t < nt; t += 2) {
            const bool last = (t == nt - 2);
            const size_t k1 = (size_t)(t + 1) * 128;
            GUnit sel;
            sel.a = last ? nxt.a : cur.a + (size_t)(t + 2) * 128; sel.b = last ? nxt.b : cur.b + (size_t)(t + 2) * 128;
            sel.hsA = last ? nxt.hsA : cur.hsA; sel.hsB = last ? nxt.hsB : cur.hsB;
#pragma unroll
            for (int i = 0; i < 2; ++i) { sel.offA[i] = last ? nxt.offA[i] : cur.offA[i]; sel.offB[i] = last ? nxt.offB[i] : cur.offB[i]; if constexpr (GA) sel.offA1[i] = last ? nxt.offA1[i] : cur.offA1[i]; }
            PG8_LDB(B0, 0, 0); PG8_LDB(B1, 0, 1); PG8_SCHED; PG8_LDA(At, 0, 0); PG8_STA(PG8_SA(1, 1), cur, 1, k1);
            PG8_WAIT_V(8); PG8_WAIT_L(0); PG8_BAR; PG8_MMA(0, 0, At, B0); PG8_MMA(0, 1, At, B1); PG8_BAR; PG8_SCHED;
            PG8_LDA(At, 0, 1); PG8_STB(PG8_SB(0, 0), sel, 0, 0); PG8_STB(PG8_SB(0, 1), sel, 1, 0); PG8_STA(PG8_SA(0, 0), sel, 0, 0);
            PG8_WAIT_V(8); PG8_WAIT_L(0); PG8_BAR; PG8_MMA(1, 0, At, B0); PG8_MMA(1, 1, At, B1); PG8_BAR; PG8_SCHED;
            PG8_LDB(B0, 1, 0); PG8_LDB(B1, 1, 1); PG8_SCHED; PG8_LDA(At, 1, 0); PG8_STA(PG8_SA(0, 1), sel, 1, 0);
            PG8_WAIT_V(8); PG8_WAIT_L(0); PG8_BAR; PG8_MMA(0, 0, At, B0); PG8_MMA(0, 1, At, B1); PG8_BAR; PG8_SCHED;
            PG8_LDA(At, 1, 1); PG8_STB(PG8_SB(1, 0), sel, 0, 128); PG8_STB(PG8_SB(1, 1), sel, 1, 128); PG8_STA(PG8_SA(1, 0), sel, 0, 128);
            PG8_WAIT_V(8); PG8_WAIT_L(0); PG8_BAR; PG8_MMA(1, 0, At, B0); PG8_MMA(1, 1, At, B1); PG8_BAR; PG8_SCHED;
        }
        if constexpr (ALIGN_EPI) { if (wr == 0) PG8_BAR; }
        E(acc, cur, wr, wc, fr, fq);
        if (!has_next) break;
#pragma unroll
        for (int a = 0; a < 2; ++a)
#pragma unroll
            for (int b = 0; b < 2; ++b)
#pragma unroll
                for (int m = 0; m < 4; ++m)
#pragma unroll
                    for (int n = 0; n < 2; ++n) acc[a][b][m][n] = (f32x4){0.f, 0.f, 0.f, 0.f};
        cur = nxt; ++ui;
        if constexpr (ALIGN_EPI) { if (wr == 1) PG8_BAR; }
    }
    PG8_WAIT_V(0);
    if constexpr (!ALIGN_EPI) { if (wr == 0) PG8_BAR; }
    PG8_BAR;
#undef PG8_SA
#undef PG8_SB
#undef PG8_STAGE
#undef PG8_STA
#undef PG8_STB
#undef PG8_LDA
#undef PG8_LDB
#undef PG8_MMA
#undef PG8_WAIT_V
#undef PG8_WAIT_L
#undef PG8_BAR
#undef PG8_SCHED
}

__device__ __forceinline__ void tile_of(int wgid, int nM, int nN, int& pm, int& pn) {
    const int WGM = 8, nig = WGM * nN, gid = wgid / nig, fm = gid * WGM, gsz = (nM - fm) < WGM ? (nM - fm) : WGM;
    pm = fm + ((wgid % nig) % gsz); pn = (wgid % nig) / gsz;
}
__device__ __forceinline__ void dense_offsets(GUnit& u, const LaneGeom& g, int lda_bytes, int ldb_bytes, bool perm) {
    u.hsA = 128 * lda_bytes; u.hsB = 128 * ldb_bytes;
#pragma unroll
    for (int i = 0; i < 2; ++i) {
        u.offA[i] = (unsigned)(g.R[i] * lda_bytes + g.C[i] * 2); u.offA1[i] = 0u;
        u.offB[i] = (unsigned)((perm ? g.Rp[i] : g.R[i]) * ldb_bytes + g.C[i] * 2);
    }
}
}
using pg8::GUnit; using pg8::LaneGeom;

struct Params {
    const float* x; const float* mem; const int* positions;
    const float* w_in; const float* w_mem_kv; const float* w_gate; const float* b_gate;
    const float* w_br_dil; const float* w_br_moba; const float* w_br_mem; const float* w_out;
    const float* ln1_g; const float* ln1_b; const float* w_router; const float* router_bias;
    const float* w_e_gate; const float* w_e_up; const float* w_e_down;
    const float* w_s_gate; const float* w_s_up; const float* w_s_down; const float* ln2_g; const float* ln2_b;
    float* out; unsigned char* ws;
};

__device__ __forceinline__ void transpose_item(const float* W, int N, bf16_t* WT, int dld, int k0, int n0, int drow0, LAS float* scr, int lane) {
#pragma unroll 8
    for (int i = 0; i < 32; ++i) { const int kk = 2 * i + (lane >> 5); scr[kk * 33 + (lane & 31)] = W[(size_t)(k0 + kk) * N + n0 + (lane & 31)]; }
    LDS_WAIT(); asm volatile("" ::: "memory");
    const int c = lane & 7;
#pragma unroll
    for (int j = 0; j < 4; ++j) { const int n = (lane >> 3) + 8 * j; const LAS float* s = scr + (8 * c) * 33 + n;
        u32x4 o; o.x = cvtpk(s[0 * 33], s[1 * 33]); o.y = cvtpk(s[2 * 33], s[3 * 33]); o.z = cvtpk(s[4 * 33], s[5 * 33]); o.w = cvtpk(s[6 * 33], s[7 * 33]);
        *(u32x4*)(WT + (size_t)(drow0 + n) * dld + k0 + 8 * c) = o; }
    LDS_WAIT(); asm volatile("" ::: "memory");
}
__device__ __forceinline__ bool p0_seg(int& r, const float* W, int K, int N, bf16_t* WT, int dld, int mode  , int row_off, LAS float* scr, int lane) {
    const int nblk = N / 32, items = (K / 64) * nblk;
    if (r >= items) { r -= items; return false; }
    const int kb = r / nblk, nb = r % nblk, n0 = 32 * nb;
    const int drow0 = row_off + (mode == 0 ? n0 : 256 * (n0 >> 7) + (n0 & 127) + (mode == 2 ? 128 : 0));
    transpose_item(W, N, WT, dld, 64 * kb, n0, drow0, scr, lane);
    return true;
}
__device__ __forceinline__ void p0_prologue(const Params& P, LAS unsigned char* lds, int gw, int NGW, int gtid, int NTHR, int lane, int wave) {
    unsigned char* ws = P.ws;
    LAS float* scr = (LAS float*)(lds + wave * 16384);
    constexpr int SMALL_ITEMS = 1280 + 1536 + 256 + 64 + 192 + 128 + 512 + 128 + 128 + 128 + 128;
    constexpr int EXP_ITEMS = 128;
    constexpr int NITEMS = SMALL_ITEMS + 3 * NEXP * EXP_ITEMS;
    for (int it = gw; it < NITEMS; it += NGW) {
        int r = it;
        if (r < SMALL_ITEMS) {
            if (p0_seg(r, P.w_in, 1024, WIN, (bf16_t*)(ws + WS_WTQG), 1024, 0, 0, scr, lane)) continue;
            if (p0_seg(r, P.w_gate, 1024, NGATE, (bf16_t*)(ws + WS_WTQG), 1024, 0, WIN, scr, lane)) continue;
            if (p0_seg(r, P.w_mem_kv, 1024, 512, (bf16_t*)(ws + WS_WTKV), 1024, 0, 0, scr, lane)) continue;
            if (p0_seg(r, P.w_br_dil, 128, 1024, (bf16_t*)(ws + WS_WTBRD), 128, 0, 0, scr, lane)) continue;
            if (p0_seg(r, P.w_br_moba, 384, 1024, (bf16_t*)(ws + WS_WTBRM), 384, 0, 0, scr, lane)) continue;
            if (p0_seg(r, P.w_br_mem, 256, 1024, (bf16_t*)(ws + WS_WTBRX), 256, 0, 0, scr, lane)) continue;
            if (p0_seg(r, P.w_out, 1024, 1024, (bf16_t*)(ws + WS_WTOUT), 1024, 0, 0, scr, lane)) continue;
            if (p0_seg(r, P.w_router, 1024, 256, (bf16_t*)(ws + WS_WTRS), 1024, 0, 0, scr, lane)) continue;
            if (p0_seg(r, P.w_s_gate, 1024, 256, (bf16_t*)(ws + WS_WTRS), 1024, 1, 256, scr, lane)) continue;
            if (p0_seg(r, P.w_s_up, 1024, 256, (bf16_t*)(ws + WS_WTRS), 1024, 2, 256, scr, lane)) continue;
            p0_seg(r, P.w_s_down, 256, 1024, (bf16_t*)(ws + WS_WTSD), 256, 0, 0, scr, lane);
        } else {
            r -= SMALL_ITEMS;
            const int which = r / (NEXP * EXP_ITEMS); r -= which * (NEXP * EXP_ITEMS);
            const int e = r / EXP_ITEMS; r -= e * EXP_ITEMS;
            if (which == 0) p0_seg(r, P.w_e_gate + (size_t)e * 1024 * 256, 1024, 256, (bf16_t*)(ws + WS_W1T) + (size_t)e * 512 * 1024, 1024, 1, 0, scr, lane);
            else if (which == 1) p0_seg(r, P.w_e_up + (size_t)e * 1024 * 256, 1024, 256, (bf16_t*)(ws + WS_W1T) + (size_t)e * 512 * 1024, 1024, 2, 0, scr, lane);
            else p0_seg(r, P.w_e_down + (size_t)e * 256 * 1024, 256, 1024, (bf16_t*)(ws + WS_W2T) + (size_t)e * 1024 * 256, 256, 0, 0, scr, lane);
        }
    }
    for (int c = gtid; c < NTOK * DM / 8; c += NTHR) { const f32x4 a = *(const f32x4*)(P.x + (size_t)c * 8), b = *(const f32x4*)(P.x + (size_t)c * 8 + 4); *(u32x4*)((bf16_t*)(ws + WS_XB) + (size_t)c * 8) = pack8(a, b); }
    for (int c = gtid; c < 2048 * DM / 8; c += NTHR) { const f32x4 a = *(const f32x4*)(P.mem + (size_t)c * 8), b = *(const f32x4*)(P.mem + (size_t)c * 8 + 4); *(u32x4*)((bf16_t*)(ws + WS_MEMB) + (size_t)c * 8) = pack8(a, b); }
    for (int tkn = gtid; tkn < NTOK; tkn += NTHR) {
        const double p = (double)P.positions[tkn]; float* o = (float*)(ws + WS_ROPE) + (size_t)tkn * 16;
#define ROPE_J(j, f) { const double a = p * (double)(f); const double rv = a * 0.15915494309189535; const double fr_ = rv - __builtin_rint(rv); const float ang = (float)(fr_ * 6.283185307179586); o[j] = cosf(ang); o[8 + j] = sinf(ang); }
        ROPE_J(0, 1.0f) ROPE_J(1, 0.1939227432012558f) ROPE_J(2, 0.03760603070259094f) ROPE_J(3, 0.007292664609849453f)
        ROPE_J(4, 0.0014142135623842478f) ROPE_J(5, 0.00027424818836152554f) ROPE_J(6, 5.318296098266728e-05f) ROPE_J(7, 1.0313386155758053e-05f)
#undef ROPE_J
    }
    unsigned* ctl = (unsigned*)(ws + WS_CTL);
    for (int i = gtid; i < 8192 + 49152; i += NTHR) ctl[i] = 0u;
}

struct SchedP1 {
    static constexpr bool GATHER = false;
    LaneGeom g; int G, c; const unsigned char* ws;
    __device__ __forceinline__ bool next(int i, GUnit& u) const {
        const int L = i * G + c; if (L >= 2816 + 16) return false;
        if (L < 2816) { const int wgid = pg8::xcd_remap(L, 2816); pg8::tile_of(wgid, 128, 22, u.pm, u.pn);
            u.a = (const char*)(ws + WS_XB) + (size_t)u.pm * 256 * 2048; u.b = (const char*)(ws + WS_WTQG) + (size_t)u.pn * 256 * 2048; u.kind = u.pn < 10 ? 0 : 1; }
        else { const int j = L - 2816; u.pm = j >> 1; u.pn = j & 1; u.kind = 2;
            u.a = (const char*)(ws + WS_MEMB) + (size_t)u.pm * 256 * 2048; u.b = (const char*)(ws + WS_WTKV) + (size_t)u.pn * 256 * 2048; }
        u.nt = 16; u.aux = 0; pg8::dense_offsets(u, g, 2048, 2048, true); return true;
    }
};
struct EpiP1 {
    bf16_t* qkv; bf16_t* gates; bf16_t* kvm; const float* bgate; const float* rope; float* ksum;
    __device__ __forceinline__ void operator()(const f32x4 (&acc)[2][2][4][2], const GUnit& u, int wr, int wc, int fr, int fq) const {
        const int row0 = u.pm * 256 + wr * 64 + fr;
        if (u.kind == 0) {
#pragma unroll
            for (int bj = 0; bj < 2; ++bj) {
                const int colbase = u.pn * 256 + 128 * bj + 32 * wc, head = colbase >> 6;
                const bool rope_head = head < 12 || (head >= 18 && head < 30);
                const bool rot = rope_head && ((colbase & 63) == 0);
                const bool qhead = head < 6 || (head >= 18 && head < 24) || head >= 36;
                const bool khead = head >= 24 && head < 30;
                const float sc = qhead ? C2 : 1.0f;
                f32x4 cs0 = {0.f, 0.f, 0.f, 0.f}, cs1 = {0.f, 0.f, 0.f, 0.f};
#pragma unroll
                for (int ai = 0; ai < 2; ++ai)
#pragma unroll
                    for (int m = 0; m < 4; ++m) {
                        const int row = row0 + 128 * ai + 16 * m;
                        f32x4 v0 = acc[ai][bj][m][0], v1 = acc[ai][bj][m][1];
                        if (rot) {
                            f32x4 p0, p1;
#pragma unroll
                            for (int e = 0; e < 4; ++e) { p0[e] = __shfl_xor(v0[e], 16); p1[e] = __shfl_xor(v1[e], 16); }
                            const float* rp = rope + (size_t)row * 16;
                            const f32x4 c0 = *(const f32x4*)(rp), c1 = *(const f32x4*)(rp + 4), s0 = *(const f32x4*)(rp + 8), s1 = *(const f32x4*)(rp + 12);
                            if (fq == 0) { v0 = v0 * c0 - p0 * s0; v1 = v1 * c1 - p1 * s1; }
                            else if (fq == 1) { v0 = v0 * c0 + p0 * s0; v1 = v1 * c1 + p1 * s1; }
                        }
                        v0 = v0 * sc; v1 = v1 * sc;
                        if (khead) { cs0 += v0; cs1 += v1; }
                        *(u32x4*)(qkv + (size_t)row * WIN + colbase + 8 * fq) = pack8(v0, v1);
                    }
                if (khead) {
#pragma unroll
                    for (int e = 0; e < 4; ++e) {
#pragma unroll
                        for (int o = 1; o < 16; o <<= 1) { cs0[e] += __shfl_xor(cs0[e], o); cs1[e] += __shfl_xor(cs1[e], o); }
                    }
                    if (fr == 0) { float* kp = ksum + ((size_t)u.pm * 6 + (head - 24)) * 64 + (colbase & 63) + 8 * fq;
#pragma unroll
                        for (int e = 0; e < 4; ++e) { atomicAdd(kp + e, cs0[e]); atomicAdd(kp + 4 + e, cs1[e]); } }
                }
            }
        } else if (u.kind == 1) {
#pragma unroll
            for (int bj = 0; bj < 2; ++bj) {
                const int col = (u.pn - 10) * 256 + 128 * bj + 32 * wc + 8 * fq;
                const f32x4 b0 = *(const f32x4*)(bgate + col), b1 = *(const f32x4*)(bgate + col + 4);
#pragma unroll
                for (int ai = 0; ai < 2; ++ai)
#pragma unroll
                    for (int m = 0; m < 4; ++m) {
                        const int row = row0 + 128 * ai + 16 * m;
                        f32x4 v0 = acc[ai][bj][m][0] + b0, v1 = acc[ai][bj][m][1] + b1;
#pragma unroll
                        for (int e = 0; e < 4; ++e) { v0[e] = fast_sigmoid(v0[e]); v1[e] = fast_sigmoid(v1[e]); }
                        *(u32x4*)(gates + (size_t)row * NGATE + col) = pack8(v0, v1);
                    }
            }
        } else {
#pragma unroll
            for (int bj = 0; bj < 2; ++bj) {
                const int col = u.pn * 256 + 128 * bj + 32 * wc + 8 * fq;
#pragma unroll
                for (int ai = 0; ai < 2; ++ai)
#pragma unroll
                    for (int m = 0; m < 4; ++m) { const int row = row0 + 128 * ai + 16 * m; *(u32x4*)(kvm + (size_t)row * 512 + col) = pack8(acc[ai][bj][m][0], acc[ai][bj][m][1]); }
            }
        }
    }
};

struct SchedP3 {
    static constexpr bool GATHER = false;
    LaneGeom g; int G, c; const unsigned char* ws;
    __device__ __forceinline__ bool next(int i, GUnit& u) const {
        const int i3 = i / 3, br = i - 3 * i3; const int L = i3 * G + c; if (L >= 512) return false;
        const int wgid = pg8::xcd_remap(L, 512); pg8::tile_of(wgid, 128, 4, u.pm, u.pn);
        u.kind = br; u.aux = 0;
        int kb; size_t abase, bbase;
        if (br == 0) { kb = 128; abase = WS_YDIL; bbase = WS_WTBRD; } else if (br == 1) { kb = 384; abase = WS_YMOBA; bbase = WS_WTBRM; } else { kb = 256; abase = WS_YMEM; bbase = WS_WTBRX; }
        u.nt = kb / 64;
        u.a = (const char*)(ws + abase) + (size_t)u.pm * 256 * kb * 2; u.b = (const char*)(ws + bbase) + (size_t)u.pn * 256 * kb * 2;
        pg8::dense_offsets(u, g, kb * 2, kb * 2, true); return true;
    }
};
struct EpiP3 {
    const bf16_t* gates; bf16_t* merged;
    __device__ __forceinline__ void operator()(const f32x4 (&acc)[2][2][4][2], const GUnit& u, int wr, int wc, int fr, int fq) const {
        const int row0 = u.pm * 256 + wr * 64 + fr;
#pragma unroll
        for (int ai = 0; ai < 2; ++ai)
#pragma unroll
            for (int m = 0; m < 4; ++m) {
                const int row = row0 + 128 * ai + 16 * m;
#pragma unroll
                for (int bj = 0; bj < 2; ++bj) {
                    const int col = u.pn * 256 + 128 * bj + 32 * wc + 8 * fq;
                    f32x4 g0, g1; unpack8(*(const u32x4*)(gates + (size_t)row * NGATE + u.kind * 1024 + col), g0, g1);
                    f32x4 v0 = g0 * acc[ai][bj][m][0], v1 = g1 * acc[ai][bj][m][1];
                    bf16_t* mp = merged + (size_t)row * DM + col;
                    if (u.kind != 0) { f32x4 o0, o1; unpack8(*(const u32x4*)mp, o0, o1); v0 += o0; v1 += o1; }
                    *(u32x4*)mp = pack8(v0, v1);
                }
            }
    }
};

struct SchedP4 {
    static constexpr bool GATHER = false;
    LaneGeom g; int G, c; const unsigned char* ws;
    __device__ __forceinline__ bool next(int i, GUnit& u) const {
        const int L = i * G + c; if (L >= 512) return false;
        const int wgid = pg8::xcd_remap(L, 512); pg8::tile_of(wgid, 128, 4, u.pm, u.pn);
        u.kind = 0; u.aux = 0; u.nt = 16;
        u.a = (const char*)(ws + WS_MERGED) + (size_t)u.pm * 256 * 2048; u.b = (const char*)(ws + WS_WTOUT) + (size_t)u.pn * 256 * 2048;
        pg8::dense_offsets(u, g, 2048, 2048, false); return true;
    }
};
struct EpiP4 {
    const float* x; float* h1;
    __device__ __forceinline__ void operator()(const f32x4 (&acc)[2][2][4][2], const GUnit& u, int wr, int wc, int fr, int fq) const {
        const int row0 = u.pm * 256 + wr * 64 + fr, col0 = u.pn * 256 + wc * 32 + 4 * fq;
#pragma unroll
        for (int ai = 0; ai < 2; ++ai)
#pragma unroll
            for (int m = 0; m < 4; ++m) { const size_t off = (size_t)(row0 + 128 * ai + 16 * m) * DM + col0;
#pragma unroll
                for (int bj = 0; bj < 2; ++bj)
#pragma unroll
                    for (int n = 0; n < 2; ++n) { const f32x4 xv = *(const f32x4*)(x + off + bj * 128 + n * 16); *(f32x4*)(h1 + off + bj * 128 + n * 16) = xv * ALPHA + acc[ai][bj][m][n]; } }
    }
};

struct SchedP6 {
    static constexpr bool GATHER = false;
    LaneGeom g; int G, c; const unsigned char* ws;
    __device__ __forceinline__ bool next(int i, GUnit& u) const {
        const int L = i * G + c; if (L >= 384) return false;
        const int wgid = pg8::xcd_remap(L, 384); pg8::tile_of(wgid, 128, 3, u.pm, u.pn);
        u.kind = u.pn == 0 ? 0 : 1; u.aux = 0; u.nt = 16;
        u.a = (const char*)(ws + WS_X1B) + (size_t)u.pm * 256 * 2048; u.b = (const char*)(ws + WS_WTRS) + (size_t)u.pn * 256 * 2048;
        pg8::dense_offsets(u, g, 2048, 2048, u.pn != 0); return true;
    }
};
__device__ __forceinline__ void swiglu_store(const f32x4 (&acc)[2][2][4][2], bf16_t* hid, size_t row_base  , int hcol0, int wr, int wc, int fr, int fq) {
#pragma unroll
    for (int ai = 0; ai < 2; ++ai)
#pragma unroll
        for (int m = 0; m < 4; ++m) {
            const size_t row = row_base + 128 * ai + 64 * wr + 16 * m + fr;
            f32x4 h0, h1;
#pragma unroll
            for (int e = 0; e < 4; ++e) { const float g0 = acc[ai][0][m][0][e], g1 = acc[ai][0][m][1][e];
                h0[e] = g0 * fast_sigmoid(g0) * acc[ai][1][m][0][e]; h1[e] = g1 * fast_sigmoid(g1) * acc[ai][1][m][1][e]; }
            *(u32x4*)(hid + row * 256 + hcol0 + 32 * wc + 8 * fq) = pack8(h0, h1);
        }
}
struct EpiP6 {
    float* scores; bf16_t* hids;
    __device__ __forceinline__ void operator()(const f32x4 (&acc)[2][2][4][2], const GUnit& u, int wr, int wc, int fr, int fq) const {
        if (u.kind == 0) {
            const int row0 = u.pm * 256 + wr * 64 + fr, col0 = wc * 32 + 4 * fq;
#pragma unroll
            for (int ai = 0; ai < 2; ++ai)
#pragma unroll
                for (int m = 0; m < 4; ++m) { const size_t off = (size_t)(row0 + 128 * ai + 16 * m) * 256 + col0;
#pragma unroll
                    for (int bj = 0; bj < 2; ++bj)
#pragma unroll
                        for (int n = 0; n < 2; ++n) { f32x4 v = acc[ai][bj][m][n];
#pragma unroll
                            for (int e = 0; e < 4; ++e) v[e] = 1.0f / (1.0f + __expf(-v[e]));
                            *(f32x4*)(scores + off + bj * 128 + n * 16) = v; } }
        } else swiglu_store(acc, hids, (size_t)u.pm * 256, 128 * (u.pn - 1), wr, wc, fr, fq);
    }
};

struct SchedP9 {
    static constexpr bool GATHER = true;
    LaneGeom g; int G, c; const unsigned char* ws; int nwg;
    __device__ __forceinline__ bool next(int i, GUnit& u) const {
        const int L = i * G + c; if (L >= nwg) return false;
        const int wgid = pg8::xcd_remap(L, nwg); const int rt = wgid >> 1, p = wgid & 1;
        const int e = ((const int*)(ws + WS_CTL))[CW_TILEE + rt];
        u.pm = rt; u.pn = p; u.kind = 0; u.aux = e; u.nt = 16;
        u.a = (const char*)(ws + WS_X1B); u.b = (const char*)(ws + WS_W1T) + (size_t)e * (512 * 2048) + (size_t)p * 256 * 2048;
        const int* rtok = (const int*)(ws + WS_ROWTOK) + (size_t)rt * 256;
        u.hsA = 0; u.hsB = 128 * 2048;
#pragma unroll
        for (int k = 0; k < 2; ++k) { u.offA[k] = (unsigned)rtok[g.R[k]] * 2048u + (unsigned)(g.C[k] * 2); u.offA1[k] = (unsigned)rtok[128 + g.R[k]] * 2048u + (unsigned)(g.C[k] * 2); u.offB[k] = (unsigned)(g.Rp[k] * 2048 + g.C[k] * 2); }
        return true;
    }
};
struct EpiP9 {
    bf16_t* hid;
    __device__ __forceinline__ void operator()(const f32x4 (&acc)[2][2][4][2], const GUnit& u, int wr, int wc, int fr, int fq) const { swiglu_store(acc, hid, (size_t)u.pm * 256, 128 * u.pn, wr, wc, fr, fq); }
};

__device__ __forceinline__ bf16_t* y_row(unsigned char* ws, int r) { return r < Y_SPLIT ? (bf16_t*)(ws + WS_Y1) + (size_t)r * DM : (bf16_t*)(ws + WS_Y2) + (size_t)(r - Y_SPLIT) * DM; }
struct SchedP10 {
    static constexpr bool GATHER = false;
    LaneGeom g; int G, c; const unsigned char* ws; int nexp_units, nwg;
    __device__ __forceinline__ bool next(int i, GUnit& u) const {
        const int L = i * G + c; if (L >= nwg) return false;
        u.nt = 4; u.aux = 0;
        if (L < nexp_units) { const int wgid = pg8::xcd_remap(L, nexp_units); const int rt = wgid >> 2, pn = wgid & 3;
            const int e = ((const int*)(ws + WS_CTL))[CW_TILEE + rt];
            u.pm = rt; u.pn = pn; u.kind = 0;
            u.a = (const char*)(ws + WS_HID) + (size_t)rt * 256 * 512; u.b = (const char*)(ws + WS_W2T) + (size_t)e * (1024 * 512) + (size_t)pn * 256 * 512;
            pg8::dense_offsets(u, g, 512, 512, true);
        } else { const int j = L - nexp_units; const int wgid = pg8::xcd_remap(j, 512); pg8::tile_of(wgid, 128, 4, u.pm, u.pn); u.kind = 1;
            u.a = (const char*)(ws + WS_HIDS) + (size_t)u.pm * 256 * 512; u.b = (const char*)(ws + WS_WTSD) + (size_t)u.pn * 256 * 512;
            pg8::dense_offsets(u, g, 512, 512, false);
        }
        return true;
    }
};
struct EpiP10 {
    unsigned char* ws; const int* row_y; const float* row_w; float* x1f;
    __device__ __forceinline__ void operator()(const f32x4 (&acc)[2][2][4][2], const GUnit& u, int wr, int wc, int fr, int fq) const {
        if (u.kind == 0) {
#pragma unroll
            for (int ai = 0; ai < 2; ++ai)
#pragma unroll
                for (int m = 0; m < 4; ++m) {
                    const int d = u.pm * 256 + 128 * ai + 64 * wr + 16 * m + fr;
                    const int ry = row_y[d]; const float w = row_w[d];
                    if (ry >= 0) { bf16_t* yp = y_row(ws, ry) + u.pn * 256 + 32 * wc + 8 * fq;
#pragma unroll
                        for (int bj = 0; bj < 2; ++bj) *(u32x4*)(yp + 128 * bj) = pack8(acc[ai][bj][m][0] * w, acc[ai][bj][m][1] * w); }
                }
        } else {
            const int row0 = u.pm * 256 + wr * 64 + fr, col0 = u.pn * 256 + wc * 32 + 4 * fq;
#pragma unroll
            for (int ai = 0; ai < 2; ++ai)
#pragma unroll
                for (int m = 0; m < 4; ++m) { const size_t off = (size_t)(row0 + 128 * ai + 16 * m) * DM + col0;
#pragma unroll
                    for (int bj = 0; bj < 2; ++bj)
#pragma unroll
                        for (int n = 0; n < 2; ++n) { float* p = x1f + off + bj * 128 + n * 16; const f32x4 xv = *(const f32x4*)p; *(f32x4*)p = xv * ALPHA + acc[ai][bj][m][n]; } }
        }
    }
};

namespace att {
constexpr int SLOTB = 8192, LDS_K = 0, LDS_V = 2 * SLOTB, LDS_WS = 4 * SLOTB, LDS_OST = LDS_WS + 8 * 256, LDS_BYTES = LDS_OST + 8 * 4096;
typedef short v4i16_t __attribute__((ext_vector_type(4)));
__device__ __forceinline__ int crow(int r, int hi) { return (r & 3) + 8 * (r >> 2) + 4 * hi; }
__device__ __forceinline__ void glds16(const void* gsrc, unsigned lds_dst) { unsigned keep;
    asm volatile("s_mov_b32 %0, m0\n\ts_mov_b32 m0, %2\n\ts_nop 0\n\tglobal_load_lds_dwordx4 %1, off\n\ts_mov_b32 m0, %0" : "=&s"(keep) : "v"(gsrc), "s"(lds_dst) : "memory"); }
__device__ __forceinline__ s16x4 vtr(LAS const char* p) { return __builtin_bit_cast(s16x4, __builtin_amdgcn_ds_read_tr16_b64_v4i16((LAS v4i16_t*)p)); }
__device__ __forceinline__ float rowmax32(const f32x16& p0, const f32x16& p1) {
    float a = p0[0];
#pragma unroll
    for (int r = 1; r < 16; ++r) a = __builtin_fmaxf(a, p0[r]);
#pragma unroll
    for (int r = 0; r < 16; ++r) a = __builtin_fmaxf(a, p1[r]);
    auto rr = __builtin_amdgcn_permlane32_swap(__float_as_uint(a), __float_as_uint(a), false, false);
    return __builtin_fmaxf(__uint_as_float(rr[0]), __uint_as_float(rr[1]));
}
struct Desc {
    const bf16_t* q; long qs;
    const bf16_t* k; const bf16_t* v; long kvs; int key0;
    bf16_t* o; long os;
    float* lse; long lses;
    int nt;
    int mode;
    int qb;
    const float* ksum;
};
template <int MODE>
__device__ __forceinline__ void attn_unit(LAS char* shm, const Desc& D) {
    const int tid = threadIdx.x, lane = tid & 63, r32 = lane & 31, hi = lane >> 5; const int wid = __builtin_amdgcn_readfirstlane(tid >> 6);
    const unsigned lds0 = (unsigned)(uintptr_t)shm;
    LAS float* wsf = (LAS float*)(shm + LDS_WS) + wid * 64;
    const bf16_t* Qw = D.q + (long)(wid * 32 + r32) * D.qs;
    bf16x8 qr[4];
#pragma unroll
    for (int d0 = 0; d0 < 4; ++d0) qr[d0] = *(const bf16x8*)(Qw + d0 * 16 + hi * 8);
    unsigned selmask = 0u;
    if constexpr (MODE == 1) {
        f32x16 gacc = {};
        const int n = lane & 31;
#pragma unroll
        for (int d0 = 0; d0 < 4; ++d0) {
            bf16x8 a = {};
            if (n < 16) { const float* kp = D.ksum + (size_t)n * (6 * 64) + 16 * d0 + 8 * hi; const f32x4 x0 = *(const f32x4*)kp, x1 = *(const f32x4*)(kp + 4); a = __builtin_bit_cast(bf16x8, pack8(x0 * (1.0f / 256.0f), x1 * (1.0f / 256.0f))); }
            gacc = __builtin_amdgcn_mfma_f32_32x32x16_bf16(a, qr[d0], gacc, 0, 0, 0);
        }
        float cv[16]; int cn[16];
#pragma unroll
        for (int r = 0; r < 8; ++r) { cv[r] = gacc[r]; cn[r] = crow(r, hi); cv[8 + r] = __shfl_xor(gacc[r], 32); cn[8 + r] = crow(r, hi ^ 1); }
#pragma unroll
        for (int rep = 0; rep < 3; ++rep) {
            float best = NEG_INF; int bi = -1;
#pragma unroll
            for (int c = 0; c < 16; ++c) { const bool ok = cn[c] < D.qb && !((selmask >> cn[c]) & 1u); const bool better = ok && (bi < 0 || cv[c] > best || (cv[c] == best && cn[c] < bi)); if (better) { best = cv[c]; bi = cn[c]; } }
            if (bi >= 0) selmask |= 1u << bi;
        }
    }
    float mrun = NEG_INF, lrun = 0.f; f32x16 o[2]; o[0] = f32x16{}; o[1] = f32x16{};
    const int NT = D.nt;
    const LAS char* kp0 = (const LAS char*)shm + LDS_K + hi * 1024 + r32 * 16;
    const LAS char* vp0 = (const LAS char*)shm + LDS_V + ((lane >> 4) & 1) * 32 + (lane & 3) * 8 + (4 * hi + ((lane & 15) >> 2)) * 64;
    auto ktile = [&](int t) -> int { if constexpr (MODE == 1) return t < 4 ? (NT - 4 + t) : (t - 4); else return t; };
    auto dma = [&](int t, int slot) {
        const int kt = ktile(t);
        int krow = D.key0 + 64 * kt + lane; krow = krow < 0 ? 0 : krow;
        int vrow = D.key0 + 64 * kt + 16 * (wid & 3) + (lane >> 2); vrow = vrow < 0 ? 0 : vrow;
        glds16(D.k + (long)krow * D.kvs + wid * 8, (unsigned)__builtin_amdgcn_readfirstlane(lds0 + LDS_K + slot * SLOTB + wid * 1024));
        glds16(D.v + (long)vrow * D.kvs + (wid >> 2) * 32 + (lane & 3) * 8, (unsigned)__builtin_amdgcn_readfirstlane(lds0 + LDS_V + slot * SLOTB + wid * 1024));
    };
    dma(0, 0);
#pragma unroll 1
    for (int t = 0; t < NT; ++t) {
        asm volatile("s_waitcnt vmcnt(0) lgkmcnt(0)\n\ts_barrier" ::: "memory");
        if (t + 1 < NT) dma(t + 1, (t + 1) & 1);
        const int slot = t & 1, kt = ktile(t);
        bool relevant = true; bool lane_sel = true;
        if constexpr (MODE == 1) {
            if (t < 4) relevant = (64 * t) <= (32 * wid + 31);
            else { lane_sel = (selmask >> (kt >> 2)) & 1u; relevant = __any(lane_sel); }
        }
        if constexpr (MODE == 2) { const int q0 = 32 * wid; relevant = (64 * kt - 128 <= q0 + 31) && (64 * kt - 65 >= q0 - 128) && (D.key0 + 64 * kt + 63 >= 0); }
        if (relevant) {
            f32x16 p0 = {}, p1 = {};
            const LAS char* kb = kp0 + slot * SLOTB;
#pragma unroll
            for (int d0 = 0; d0 < 4; ++d0) {
                const bf16x8 b0 = *(const LAS bf16x8*)(kb + d0 * 2048), b1 = *(const LAS bf16x8*)(kb + d0 * 2048 + 512);
                p0 = __builtin_amdgcn_mfma_f32_32x32x16_bf16(b0, qr[d0], p0, 0, 0, 0); p1 = __builtin_amdgcn_mfma_f32_32x32x16_bf16(b1, qr[d0], p1, 0, 0, 0);
            }
            if constexpr (MODE == 1) {
                if (t < 4) { const int qrel = 32 * wid + r32, kb0 = 64 * t + 4 * hi;
#pragma unroll
                    for (int r = 0; r < 16; ++r) { const int kv = kb0 + (r & 3) + 8 * (r >> 2); if (kv > qrel) p0[r] = NEG_INF; if (kv + 32 > qrel) p1[r] = NEG_INF; } }
                else if (!lane_sel) {
#pragma unroll
                    for (int r = 0; r < 16; ++r) { p0[r] = NEG_INF; p1[r] = NEG_INF; } }
            }
            if constexpr (MODE == 2) {
                const int ql = D.qb + 32 * wid + r32, kl0 = D.key0 + 64 * kt + 4 * hi;
#pragma unroll
                for (int r = 0; r < 16; ++r) { const int kl = kl0 + (r & 3) + 8 * (r >> 2);
                    if (!(kl >= 0 && kl <= ql && ql - kl <= 128)) p0[r] = NEG_INF;
                    if (!(kl + 32 >= 0 && kl + 32 <= ql && ql - kl - 32 <= 128)) p1[r] = NEG_INF; }
            }
            const float rm = rowmax32(p0, p1);
            const float mnew = __builtin_fmaxf(mrun, rm);
            const float muse = (mnew == NEG_INF) ? 0.f : mnew;
            const float alpha = __builtin_amdgcn_exp2f(mrun - muse);
            float ps = 0.f;
#pragma unroll
            for (int r = 0; r < 16; ++r) { p0[r] = __builtin_amdgcn_exp2f(p0[r] - muse); p1[r] = __builtin_amdgcn_exp2f(p1[r] - muse); ps += p0[r] + p1[r]; }
            lrun = lrun * alpha + ps; mrun = mnew;
            if (__any(alpha != 1.0f)) {
                if (hi == 0) wsf[r32] = alpha;
                LDS_WAIT();
#pragma unroll
                for (int r = 0; r < 16; ++r) { const float f = wsf[crow(r, hi)]; o[0][r] *= f; o[1][r] *= f; }
            }
            u32x4 pw0, pw1, pw2, pw3;
            pw0 = (u32x4){cvtpk(p0[0], p0[1]), cvtpk(p0[2], p0[3]), cvtpk(p0[4], p0[5]), cvtpk(p0[6], p0[7])};
            pw1 = (u32x4){cvtpk(p0[8], p0[9]), cvtpk(p0[10], p0[11]), cvtpk(p0[12], p0[13]), cvtpk(p0[14], p0[15])};
            pw2 = (u32x4){cvtpk(p1[0], p1[1]), cvtpk(p1[2], p1[3]), cvtpk(p1[4], p1[5]), cvtpk(p1[6], p1[7])};
            pw3 = (u32x4){cvtpk(p1[8], p1[9]), cvtpk(p1[10], p1[11]), cvtpk(p1[12], p1[13]), cvtpk(p1[14], p1[15])};
            const LAS char* vb = vp0 + slot * SLOTB;
#pragma unroll
            for (int d0 = 0; d0 < 2; ++d0) {
                s16x4 lo[4], hh[4];
#pragma unroll
                for (int ks = 0; ks < 4; ++ks) { lo[ks] = vtr(vb + d0 * 4096 + ks * 1024); hh[ks] = vtr(vb + d0 * 4096 + ks * 1024 + 512); }
#define ATT_PK(k) (bf16x8){lo[k][0], lo[k][1], lo[k][2], lo[k][3], hh[k][0], hh[k][1], hh[k][2], hh[k][3]}
                o[d0] = __builtin_amdgcn_mfma_f32_32x32x16_bf16(__builtin_bit_cast(bf16x8, pw0), ATT_PK(0), o[d0], 0, 0, 0);
                o[d0] = __builtin_amdgcn_mfma_f32_32x32x16_bf16(__builtin_bit_cast(bf16x8, pw1), ATT_PK(1), o[d0], 0, 0, 0);
                o[d0] = __builtin_amdgcn_mfma_f32_32x32x16_bf16(__builtin_bit_cast(bf16x8, pw2), ATT_PK(2), o[d0], 0, 0, 0);
                o[d0] = __builtin_amdgcn_mfma_f32_32x32x16_bf16(__builtin_bit_cast(bf16x8, pw3), ATT_PK(3), o[d0], 0, 0, 0);
#undef ATT_PK
            }
        }
    }
    { auto rr = __builtin_amdgcn_permlane32_swap(__float_as_uint(lrun), __float_as_uint(lrun), false, false); lrun = __uint_as_float(rr[0]) + __uint_as_float(rr[1]); }
    if (hi == 0) wsf[32 + r32] = lrun;
    if (D.lse != nullptr && hi == 0) D.lse[(long)(wid * 32 + r32) * D.lses] = mrun + __builtin_amdgcn_logf(lrun);
    LDS_WAIT();
    bf16_t* Ow = D.o + (long)(wid * 32) * D.os;
    {
        LAS bf16_t* stg = (LAS bf16_t*)(shm + LDS_OST) + wid * 2048;
#pragma unroll
        for (int r = 0; r < 16; ++r) { const int orow = crow(r, hi); const float rli = __builtin_amdgcn_rcpf(wsf[32 + orow]);
#pragma unroll
            for (int d0 = 0; d0 < 2; ++d0) stg[orow * 64 + d0 * 32 + r32] = (bf16_t)(cvtpk(o[d0][r] * rli, 0.f) & 0xffffu); }
        LDS_WAIT();
#pragma unroll
        for (int i = 0; i < 4; ++i) { const int row = i * 8 + (lane >> 3), ch = lane & 7; const u32x4 v = *(const LAS u32x4*)(stg + row * 64 + ch * 8); *(u32x4*)(Ow + (long)row * D.os + ch * 8) = v; }
    }
    asm volatile("s_waitcnt lgkmcnt(0)\n\ts_barrier" ::: "memory");
}
}

constexpr int NWAVES = 8, NTHREADS = NWAVES * 64;
constexpr int RING_BYTES = 131072, MISC_OFF = RING_BYTES, LDS_BYTES = 147456;

#ifndef PHASE_MASK
#define PHASE_MASK 0xFFFF
#endif
#define PH(k) (((PHASE_MASK) >> (k)) & 1)
#ifndef ATT_MASK
#define ATT_MASK 7
#endif
#define ATT_EN(k) (((ATT_MASK) >> (k)) & 1)
__global__ void __launch_bounds__(NTHREADS, 2) fwd_megakernel(Params P) {
    extern __shared__ __attribute__((aligned(16))) unsigned char lds_raw[];
    cg::grid_group grid = cg::this_grid();
    LAS unsigned char* lds = (LAS unsigned char*)lds_raw;
    unsigned char* ws = P.ws;
    const int tid = threadIdx.x, lane = tid & 63, wave = __builtin_amdgcn_readfirstlane(tid >> 6);
    const int G = gridDim.x, bx = blockIdx.x;
    const int gw = bx * NWAVES + wave, NGW = G * NWAVES, gtid = bx * NTHREADS + tid, NTHR = G * NTHREADS;
    unsigned* ctl = (unsigned*)(ws + WS_CTL);

    if constexpr (PH(0)) p0_prologue(P, lds, gw, NGW, gtid, NTHR, lane, wave);
    grid.sync();

    if constexpr (PH(1)) {
        LaneGeom geom; geom.init(tid);
        SchedP1 S{geom, G, bx, ws};
        EpiP1 E{(bf16_t*)(ws + WS_QKV), (bf16_t*)(ws + WS_GATES), (bf16_t*)(ws + WS_KVM), P.b_gate, (const float*)(ws + WS_ROPE), (float*)(ctl + CW_KSUM)};
        pg8::gemm_phase<EpiP1, SchedP1, true>(lds, S, E);
    }
    grid.sync();

    if constexpr (PH(2)) {
        LAS int* qslot = (LAS int*)(lds + MISC_OFF);
        const bf16_t* qkv = (const bf16_t*)(ws + WS_QKV);
#define ATT_POP(base, count) int idx; { if (tid == 0) qslot[0] = (int)atomicAdd(ctl + CW_QUEUE + (base), 1u); __syncthreads(); idx = __builtin_amdgcn_readfirstlane(qslot[0]); __syncthreads(); } if (idx >= (count)) break;
        if (ATT_EN(1)) for (;;) {
            ATT_POP(0, 768)
            att::Desc D;
            const int qb = 15 - idx / 48, bh = idx % 48, b = bh / 6, h = bh % 6;
            const size_t tok0 = (size_t)b * SEQ;
            D.q = qkv + (tok0 + 256 * qb) * WIN + 1152 + h * 64; D.qs = WIN;
            D.k = qkv + tok0 * WIN + 1536 + h * 64; D.v = qkv + tok0 * WIN + 1920 + h * 64; D.kvs = WIN; D.key0 = 0;
            D.o = (bf16_t*)(ws + WS_YMOBA) + (tok0 + 256 * qb) * 384 + h * 64; D.os = 384; D.lse = nullptr; D.lses = 0;
            D.nt = 4 * qb + 4; D.mode = 1; D.qb = qb; D.ksum = (const float*)(ctl + CW_KSUM) + ((size_t)b * 16 * 6 + h) * 64;
            att::attn_unit<1>((LAS char*)lds, D);
        }
        if (ATT_EN(2)) for (;;) {
            ATT_POP(1, 768)
            att::Desc D;
            const int bh = idx >> 4, sub = idx & 15, b = bh / 6, hd = bh % 6, gI = hd >> 1;
            const int dil = gI == 0 ? 1 : (gI == 1 ? 4 : 16);
            const int res = gI == 0 ? 0 : (gI == 1 ? (sub & 3) : sub), ub = gI == 0 ? sub : (gI == 1 ? (sub >> 2) : 0);
            const size_t tok0 = (size_t)b * SEQ + res;
            D.q = qkv + (tok0 + (size_t)256 * ub * dil) * WIN + hd * 64; D.qs = (long)dil * WIN;
            D.k = qkv + tok0 * WIN + 384 + hd * 64; D.v = qkv + tok0 * WIN + 768 + hd * 64; D.kvs = (long)dil * WIN; D.key0 = 256 * ub - 128;
            D.o = (bf16_t*)(ws + WS_ODIL) + (tok0 + (size_t)256 * ub * dil) * 384 + hd * 64; D.os = (long)dil * 384;
            D.lse = (float*)(ws + WS_LSE) + (tok0 + (size_t)256 * ub * dil) * 6 + hd; D.lses = (long)dil * 6;
            D.nt = 6; D.mode = 2; D.qb = 256 * ub; D.ksum = nullptr;
            att::attn_unit<2>((LAS char*)lds, D);
        }
        if (ATT_EN(0)) for (;;) {
            ATT_POP(2, 512)
            att::Desc D;
            const int b = idx >> 6, h = (idx >> 4) & 3, qblk = idx & 15;
            const size_t tok0 = (size_t)b * SEQ + 256 * qblk;
            const bf16_t* kvm = (const bf16_t*)(ws + WS_KVM) + (size_t)b * 256 * 512;
            D.q = qkv + tok0 * WIN + 2304 + h * 64; D.qs = WIN;
            D.k = kvm + h * 64; D.v = kvm + 256 + h * 64; D.kvs = 512; D.key0 = 0;
            D.o = (bf16_t*)(ws + WS_YMEM) + tok0 * 256 + h * 64; D.os = 256; D.lse = nullptr; D.lses = 0;
            D.nt = 4; D.mode = 0; D.qb = 0; D.ksum = nullptr;
            att::attn_unit<0>((LAS char*)lds, D);
        }
#undef ATT_POP
    }
    grid.sync();

    if constexpr (PH(3)) {
        const bf16_t* odil = (const bf16_t*)(ws + WS_ODIL); const float* lse = (const float*)(ws + WS_LSE); bf16_t* ydil = (bf16_t*)(ws + WS_YDIL);
        for (int tkn = gw; tkn < NTOK; tkn += NGW) {
            const int hg = lane >> 5, dd = (lane & 31) * 2;
            const float l0 = lse[(size_t)tkn * 6 + hg], l1 = lse[(size_t)tkn * 6 + 2 + hg], l2 = lse[(size_t)tkn * 6 + 4 + hg];
            const float mx = __builtin_fmaxf(l0, __builtin_fmaxf(l1, l2));
            const float e0 = __builtin_amdgcn_exp2f(l0 - mx), e1 = __builtin_amdgcn_exp2f(l1 - mx), e2 = __builtin_amdgcn_exp2f(l2 - mx), inv = 1.0f / (e0 + e1 + e2);
            const unsigned a0 = *(const unsigned*)(odil + (size_t)tkn * 384 + hg * 64 + dd), a1 = *(const unsigned*)(odil + (size_t)tkn * 384 + 128 + hg * 64 + dd), a2 = *(const unsigned*)(odil + (size_t)tkn * 384 + 256 + hg * 64 + dd);
            const float y0 = (e0 * bflo(a0) + e1 * bflo(a1) + e2 * bflo(a2)) * inv, y1 = (e0 * bfhi(a0) + e1 * bfhi(a1) + e2 * bfhi(a2)) * inv;
            *(unsigned*)(ydil + (size_t)tkn * 128 + hg * 64 + dd) = cvtpk(y0, y1);
        }
    }
    grid.sync();

    if constexpr (PH(4)) {
        LaneGeom geom; geom.init(tid);
        SchedP3 S{geom, G, bx, ws};
        EpiP3 E{(const bf16_t*)(ws + WS_GATES), (bf16_t*)(ws + WS_MERGED)};
        pg8::gemm_phase<EpiP3, SchedP3, true>(lds, S, E);
    }
    grid.sync();

    if constexpr (PH(5)) {
        LaneGeom geom; geom.init(tid);
        SchedP4 S{geom, G, bx, ws};
        EpiP4 E{P.x, (float*)(ws + WS_X1F)};
        pg8::gemm_phase<EpiP4, SchedP4, true>(lds, S, E);
    }
    grid.sync();

    if constexpr (PH(6)) {
        float* x1f = (float*)(ws + WS_X1F); bf16_t* x1b = (bf16_t*)(ws + WS_X1B);
        for (int row = gw; row < NTOK; row += NGW) {
            f32x4* xr = (f32x4*)(x1f + (size_t)row * DM) + lane;
            f32x4 v[4]; float s = 0.f;
#pragma unroll
            for (int j = 0; j < 4; ++j) { v[j] = xr[64 * j]; s += (v[j][0] + v[j][1]) + (v[j][2] + v[j][3]); }
            const float mean = wave_sum(s) * (1.f / DM); float s2 = 0.f;
#pragma unroll
            for (int j = 0; j < 4; ++j) { v[j] = v[j] - mean; s2 += (v[j][0] * v[j][0] + v[j][1] * v[j][1]) + (v[j][2] * v[j][2] + v[j][3] * v[j][3]); }
            const float rstd = __builtin_amdgcn_rsqf(wave_sum(s2) * (1.f / DM) + LN_EPS);
#pragma unroll
            for (int j = 0; j < 4; ++j) {
                const f32x4 gg = *((const f32x4*)P.ln1_g + lane + 64 * j), bb = *((const f32x4*)P.ln1_b + lane + 64 * j);
                const f32x4 y = v[j] * rstd * gg + bb;
                xr[64 * j] = y;
                u32x2 w; w.x = cvtpk(y[0], y[1]); w.y = cvtpk(y[2], y[3]);
                *((u32x2*)(x1b + (size_t)row * DM) + lane + 64 * j) = w;
            }
        }
    }
    grid.sync();

    if constexpr (PH(7)) {
        LaneGeom geom; geom.init(tid);
        SchedP6 S{geom, G, bx, ws};
        EpiP6 E{(float*)(ws + WS_SCORES), (bf16_t*)(ws + WS_HIDS)};
        pg8::gemm_phase<EpiP6, SchedP6, true>(lds, S, E);
    }
    grid.sync();

    if constexpr (PH(8)) {
        const float* scores = (const float*)(ws + WS_SCORES);
        int* eidx = (int*)(ws + WS_EIDX); float* gwt = (float*)(ws + WS_GWT); int* pos = (int*)(ws + WS_POS);
        const f32x4 rb = *((const f32x4*)P.router_bias + lane);
        for (int tkn = gw; tkn < NTOK; tkn += NGW) {
            const f32x4 sc = *((const f32x4*)(scores + (size_t)tkn * 256) + lane);
            float v0 = sc[0] + rb[0], v1 = sc[1] + rb[1], v2 = sc[2] + rb[2], v3 = sc[3] + rb[3];
            float hi1 = __builtin_fmaxf(__builtin_fmaxf(v0, v1), __builtin_fmaxf(v2, v3));
            float a01 = __builtin_fminf(v0, v1), a23 = __builtin_fminf(v2, v3), m01 = __builtin_fmaxf(v0, v1), m23 = __builtin_fmaxf(v2, v3);
            float hi2 = __builtin_fmaxf(__builtin_fminf(m01, m23), __builtin_fmaxf(a01, a23));
#pragma unroll
            for (int o = 1; o < 8; o <<= 1) { const float o1 = __shfl_xor(hi1, o), o2 = __shfl_xor(hi2, o); const float n1 = __builtin_fmaxf(hi1, o1), n2 = __builtin_fmaxf(__builtin_fminf(hi1, o1), __builtin_fmaxf(hi2, o2)); hi1 = n1; hi2 = n2; }
            const float gs = hi1 + hi2; const int gq = lane >> 3; int rank = 0;
#pragma unroll
            for (int j = 0; j < 8; ++j) { const float sj = __shfl(gs, 8 * j); rank += (sj > gs || (sj == gs && j < gq)) ? 1 : 0; }
            if (rank >= 4) { v0 = NEG_INF; v1 = NEG_INF; v2 = NEG_INF; v3 = NEG_INF; }
            int my_e = 0;
#pragma unroll
            for (int k = 0; k < TOPK; ++k) {
                float bv = v0; int bi = 4 * lane;
                if (v1 > bv) { bv = v1; bi = 4 * lane + 1; } if (v2 > bv) { bv = v2; bi = 4 * lane + 2; } if (v3 > bv) { bv = v3; bi = 4 * lane + 3; }
#pragma unroll
                for (int o = 1; o < 64; o <<= 1) { const float ov = __shfl_xor(bv, o); const int oi = __shfl_xor(bi, o); if (ov > bv || (ov == bv && oi < bi)) { bv = ov; bi = oi; } }
                if (lane == k) my_e = bi;
                if ((bi >> 2) == lane) { const int w = bi & 3; if (w == 0) v0 = NEG_INF; else if (w == 1) v1 = NEG_INF; else if (w == 2) v2 = NEG_INF; else v3 = NEG_INF; }
            }
            float sk = (lane < TOPK) ? scores[(size_t)tkn * 256 + my_e] : 0.f;
            float ssum = sk;
#pragma unroll
            for (int o = 1; o < 8; o <<= 1) ssum += __shfl_xor(ssum, o);
            if (lane < TOPK) {
                const unsigned r = atomicAdd(ctl + CW_COUNT + my_e, 1u);
                eidx[(size_t)tkn * 8 + lane] = my_e; gwt[(size_t)tkn * 8 + lane] = sk / ssum * 2.5f; pos[(size_t)tkn * 8 + lane] = (int)r;
            }
        }
    }
    grid.sync();

    if constexpr (PH(9)) {
        LAS int* pad_start = (LAS int*)(lds + MISC_OFF + 64);
        LAS int* cstart = pad_start + 260;
        LAS int* cnt_s = cstart + 260;
        if (wave == 0) {
            int c4[4], p4[4]; int csum = 0, psum = 0;
#pragma unroll
            for (int i = 0; i < 4; ++i) { c4[i] = (int)ctl[CW_COUNT + 4 * lane + i]; p4[i] = (c4[i] + 255) & ~255; csum += c4[i]; psum += p4[i]; }
            int cin = csum, pin = psum;
#pragma unroll
            for (int o = 1; o < 64; o <<= 1) { const int a = __shfl_up(cin, o), b = __shfl_up(pin, o); if (lane >= o) { cin += a; pin += b; } }
            int ce = cin - csum, pe = pin - psum;
#pragma unroll
            for (int i = 0; i < 4; ++i) { cstart[4 * lane + i] = ce; pad_start[4 * lane + i] = pe; cnt_s[4 * lane + i] = c4[i]; ce += c4[i]; pe += p4[i]; }
            if (lane == 63) { cstart[256] = ce; pad_start[256] = pe; }
        }
        __syncthreads();
        if (bx == 0) {
            if (tid < 256) { const int t0 = pad_start[tid] >> 8, t1 = pad_start[tid + 1] >> 8; for (int t = t0; t < t1; ++t) ctl[CW_TILEE + t] = (unsigned)tid; }
            if (tid == 0) ctl[CW_RT] = (unsigned)(pad_start[256] >> 8);
        }
        const int* eidx = (const int*)(ws + WS_EIDX); const float* gwt = (const float*)(ws + WS_GWT); int* pos = (int*)(ws + WS_POS);
        int* row_tok = (int*)(ws + WS_ROWTOK); float* row_w = (float*)(ws + WS_ROWW); int* row_y = (int*)(ws + WS_ROWY);
        for (int a = gtid; a < NASSIGN; a += NTHR) {
            const int e = eidx[a], r = pos[a]; const int d = pad_start[e] + r, cc = cstart[e] + r;
            row_tok[d] = a >> 3; row_w[d] = gwt[a]; row_y[d] = cc; pos[a] = cc;
        }
        for (int i = gtid; i < NEXP * 256; i += NTHR) {
            const int e = i >> 8, jj = cnt_s[e] + (i & 255);
            if (jj < pad_start[e + 1] - pad_start[e]) { const int d = pad_start[e] + jj; row_tok[d] = 0; row_w[d] = 0.f; row_y[d] = -1; }
        }
    }
    grid.sync();

    const int RT = (int)__builtin_amdgcn_readfirstlane(((volatile unsigned*)ctl)[CW_RT]);
    if constexpr (PH(10)) {
        LaneGeom geom; geom.init(tid);
        SchedP9 S{geom, G, bx, ws, 2 * RT};
        EpiP9 E{(bf16_t*)(ws + WS_HID)};
        pg8::gemm_phase<EpiP9, SchedP9, true>(lds, S, E);
    }
    grid.sync();

    if constexpr (PH(11)) {
        LaneGeom geom; geom.init(tid);
        SchedP10 S{geom, G, bx, ws, 4 * RT, 4 * RT + 512};
        EpiP10 E{ws, (const int*)(ws + WS_ROWY), (const float*)(ws + WS_ROWW), (float*)(ws + WS_X1F)};
        pg8::gemm_phase<EpiP10, SchedP10, true>(lds, S, E);
    }
    grid.sync();

    if constexpr (PH(12)) {
        const float* x1f = (const float*)(ws + WS_X1F); const int* pos = (const int*)(ws + WS_POS);
        for (int row = gw; row < NTOK; row += NGW) {
            const f32x4* xr = (const f32x4*)(x1f + (size_t)row * DM) + lane;
            f32x4 v[4];
#pragma unroll
            for (int j = 0; j < 4; ++j) v[j] = xr[64 * j];
#pragma unroll
            for (int k = 0; k < TOPK; ++k) {
                const int yr = __builtin_amdgcn_readfirstlane(pos[(size_t)row * 8 + k]);
                const u32x2* yp = (const u32x2*)y_row(ws, yr) + lane;
#pragma unroll
                for (int j = 0; j < 4; ++j) { const u32x2 w = yp[64 * j]; v[j][0] += bflo(w.x); v[j][1] += bfhi(w.x); v[j][2] += bflo(w.y); v[j][3] += bfhi(w.y); }
            }
            float s = 0.f;
#pragma unroll
            for (int j = 0; j < 4; ++j) s += (v[j][0] + v[j][1]) + (v[j][2] + v[j][3]);
            const float mean = wave_sum(s) * (1.f / DM); float s2 = 0.f;
#pragma unroll
            for (int j = 0; j < 4; ++j) { v[j] = v[j] - mean; s2 += (v[j][0] * v[j][0] + v[j][1] * v[j][1]) + (v[j][2] * v[j][2] + v[j][3] * v[j][3]); }
            const float rstd = __builtin_amdgcn_rsqf(wave_sum(s2) * (1.f / DM) + LN_EPS);
            f32x4* orow = (f32x4*)(P.out + (size_t)row * DM) + lane;
#pragma unroll
            for (int j = 0; j < 4; ++j) { const f32x4 gg = *((const f32x4*)P.ln2_g + lane + 64 * j), bb = *((const f32x4*)P.ln2_b + lane + 64 * j); orow[64 * j] = v[j] * rstd * gg + bb; }
        }
    }
}

extern "C" void kernel_launch(void* const* d_in, const int* in_sizes, int n_in, void* d_out, int out_size, void* d_ws, size_t ws_size, hipStream_t stream) {
    static int grid = 0;
    if (grid == 0) {
        if (n_in != 23 || out_size != NTOK * DM || ws_size < WS_END) { fprintf(stderr, "kernel_launch: unexpected shapes (n_in %d, out %d, ws %zu)\n", n_in, out_size, ws_size); grid = -1; return; }
        int dev = 0, cus = 0, per_cu = 0;
        if (hipGetDevice(&dev) != hipSuccess || hipDeviceGetAttribute(&cus, hipDeviceAttributeMultiprocessorCount, dev) != hipSuccess) { grid = -1; return; }
        if (hipFuncSetAttribute((const void*)fwd_megakernel, hipFuncAttributeMaxDynamicSharedMemorySize, LDS_BYTES) != hipSuccess) { fprintf(stderr, "kernel_launch: hipFuncSetAttribute failed\n"); grid = -1; return; }
        if (hipOccupancyMaxActiveBlocksPerMultiprocessor(&per_cu, (const void*)fwd_megakernel, NTHREADS, LDS_BYTES) != hipSuccess || per_cu < 1) { fprintf(stderr, "kernel_launch: occupancy query failed (%d)\n", per_cu); grid = -1; return; }
        grid = cus * 1;
    }
    if (grid < 0) return;
    Params p{};
    p.x = (const float*)d_in[0]; p.mem = (const float*)d_in[1]; p.positions = (const int*)d_in[2];
    p.w_in = (const float*)d_in[3]; p.w_mem_kv = (const float*)d_in[4]; p.w_gate = (const float*)d_in[5]; p.b_gate = (const float*)d_in[6];
    p.w_br_dil = (const float*)d_in[7]; p.w_br_moba = (const float*)d_in[8]; p.w_br_mem = (const float*)d_in[9]; p.w_out = (const float*)d_in[10];
    p.ln1_g = (const float*)d_in[11]; p.ln1_b = (const float*)d_in[12]; p.w_router = (const float*)d_in[13]; p.router_bias = (const float*)d_in[14];
    p.w_e_gate = (const float*)d_in[15]; p.w_e_up = (const float*)d_in[16]; p.w_e_down = (const float*)d_in[17];
    p.w_s_gate = (const float*)d_in[18]; p.w_s_up = (const float*)d_in[19]; p.w_s_down = (const float*)d_in[20]; p.ln2_g = (const float*)d_in[21]; p.ln2_b = (const float*)d_in[22];
    p.out = (float*)d_out; p.ws = (unsigned char*)d_ws;
    void* args[] = {&p};
    hipError_t e = hipLaunchCooperativeKernel((const void*)fwd_megakernel, dim3(grid), dim3(NTHREADS), args, LDS_BYTES, stream);
    if (e != hipSuccess) fprintf(stderr, "kernel_launch: cooperative launch failed: %s (grid %d)\n", hipGetErrorString(e), grid);
}
```

```cpp
#include <hip/hip_runtime.h>
#include <hip/hip_cooperative_groups.h>
#include <cstdint>
#include <cstdio>
namespace cg = cooperative_groups;

#define LAS __attribute__((address_space(3)))
typedef unsigned short bf16_t;
typedef short bf16x8 __attribute__((ext_vector_type(8)));
typedef short s16x4 __attribute__((ext_vector_type(4)));
typedef float f32x2 __attribute__((ext_vector_type(2)));
typedef float f32x4 __attribute__((ext_vector_type(4)));
typedef float f32x16 __attribute__((ext_vector_type(16)));
typedef unsigned u32x2 __attribute__((ext_vector_type(2)));
typedef unsigned u32x4 __attribute__((ext_vector_type(4)));
typedef __bf16 bf16x2_t __attribute__((ext_vector_type(2)));

constexpr int NTOK = 32768, DM = 1024, NBATCH = 8, SEQ = 4096;
constexpr int WIN = 2560, NGATE = 3072, NQG = WIN + NGATE;
constexpr int NEXP = 256, TOPK = 8;
constexpr int NASSIGN = NTOK * TOPK;
constexpr int MAXROWS = NASSIGN + NEXP * 256;
constexpr float ALPHA = 1.189207115002721f;
constexpr float C2 = 0.18033688011112042f;
constexpr float LN_EPS = 1e-5f;
constexpr float LOG2E = 1.4426950408889634f;
constexpr float NEG_INF = -__builtin_inff();

constexpr size_t MiB = (size_t)1 << 20;
constexpr size_t WS_W2T = 0;
constexpr size_t WS_X1F = 128 * MiB;
constexpr size_t WS_HIDS = 256 * MiB;
constexpr size_t WS_CTL = 272 * MiB;
constexpr size_t WS_WTQG = 273 * MiB;
constexpr size_t WS_WTKV = 284 * MiB;
constexpr size_t WS_WTBRD = 285 * MiB;
constexpr size_t WS_WTBRM = 285 * MiB + 256 * 1024;
constexpr size_t WS_WTBRX = 286 * MiB;
constexpr size_t WS_WTOUT = 287 * MiB;
constexpr size_t WS_WTRS = 289 * MiB;
constexpr size_t WS_WTSD = 291 * MiB;
constexpr size_t WS_ROPE = 292 * MiB;
constexpr size_t WS_KVM = 294 * MiB;
constexpr size_t WS_LSE = 296 * MiB;
constexpr size_t WS_EIDX = 297 * MiB;
constexpr size_t WS_GWT = 298 * MiB;
constexpr size_t WS_POS = 299 * MiB;
constexpr size_t WS_ROWTOK = 300 * MiB;
constexpr size_t WS_ROWW = 301 * MiB + 256 * 1024;
constexpr size_t WS_ROWY = 302 * MiB + 512 * 1024;
constexpr size_t WS_W1T = 304 * MiB;
constexpr size_t WS_XB = 560 * MiB;
constexpr size_t WS_ODIL = 560 * MiB;
constexpr size_t WS_YMOBA = 584 * MiB;
constexpr size_t WS_YMEM = 608 * MiB;
constexpr size_t WS_X1B = 560 * MiB;
constexpr size_t WS_QKV = 624 * MiB;
constexpr size_t WS_MERGED = 624 * MiB;
#ifdef SELFCHECK
constexpr size_t WS_YDIL = 976 * MiB;
#else
constexpr size_t WS_YDIL = 688 * MiB;
#endif
constexpr size_t WS_SCORES = 624 * MiB;
constexpr size_t WS_HID = 624 * MiB;
constexpr size_t WS_GATES = 784 * MiB;
constexpr size_t WS_MEMB = 976 * MiB;
constexpr size_t WS_Y1 = 304 * MiB;
constexpr size_t WS_Y2 = 784 * MiB;
constexpr int Y_SPLIT = 163840;
constexpr size_t WS_END = 980 * MiB;
constexpr int CW_COUNT = 0;
constexpr int CW_QUEUE = 512;
constexpr int CW_RT = 520;
constexpr int CW_TILEE = 1024;
constexpr int CW_BAR = 4096;
constexpr int CW_KSUM = 8192;

__device__ __forceinline__ unsigned cvtpk(float lo, float hi) { f32x2 v = {lo, hi}; bf16x2_t b = __builtin_convertvector(v, bf16x2_t); return __builtin_bit_cast(unsigned, b); }
__device__ __forceinline__ float bflo(unsigned w) { return __uint_as_float(w << 16); }
__device__ __forceinline__ float bfhi(unsigned w) { return __uint_as_float(w & 0xffff0000u); }
__device__ __forceinline__ float fast_sigmoid(float x) { return __builtin_amdgcn_rcpf(1.0f + __builtin_amdgcn_exp2f(-x * LOG2E)); }
__device__ __forceinline__ float wave_sum(float v) {
#pragma unroll
    for (int o = 1; o < 64; o <<= 1) v += __shfl_xor(v, o);
    return v;
}
__device__ __forceinline__ u32x4 pack8(f32x4 a, f32x4 b) { u32x4 w; w.x = cvtpk(a[0], a[1]); w.y = cvtpk(a[2], a[3]); w.z = cvtpk(b[0], b[1]); w.w = cvtpk(b[2], b[3]); return w; }
__device__ __forceinline__ void unpack8(u32x4 w, f32x4& a, f32x4& b) { a = (f32x4){bflo(w.x), bfhi(w.x), bflo(w.y), bfhi(w.y)}; b = (f32x4){bflo(w.z), bfhi(w.z), bflo(w.w), bfhi(w.w)}; }
#define LDS_WAIT() asm volatile("s_waitcnt lgkmcnt(0)" ::: "memory")
#define VM_WAIT() asm volatile("s_waitcnt vmcnt(0)" ::: "memory")

namespace pg8 {
constexpr int BM = 256, BK = 64, HALF = 128, HTB = HALF * BK * 2, STAGE_BYTES = 8 * HTB;
__device__ __forceinline__ int lds_byte(int r, int c) { const int st = (r >> 4) * 2 + (c >> 5), rr = r & 15, cc = c & 31, ob = rr * 64 + cc * 2; return st * 1024 + (ob ^ (((ob >> 9) & 1) << 5)); }
__device__ __forceinline__ void stage_rc(int b, int& R, int& C) { const int st = b / 1024, sb = b % 1024, swz = sb ^ (((sb >> 9) & 1) << 5); R = (st >> 1) * 16 + swz / 64; C = (st & 1) * 32 + (swz % 64) / 2; }
__device__ __forceinline__ int perm32(int rho) { const int n = rho >> 4, i = rho & 15; return 8 * (i >> 2) + 4 * n + (i & 3); }
__device__ __forceinline__ int xcd_remap(int L, int nwg) { const int q = nwg / 8, r = nwg % 8, xcd = L % 8, off = L / 8; return (xcd < r ? xcd * (q + 1) : r * (q + 1) + (xcd - r) * q) + off; }

struct GUnit {
    const char* a; const char* b;
    int nt;
    int pm, pn, kind, aux;
    int hsA, hsB;
    unsigned offA[2], offB[2];
    unsigned offA1[2];
};
struct LaneGeom {
    int R[2], C[2], Rp[2];
    __device__ __forceinline__ void init(int tid) {
#pragma unroll
        for (int i = 0; i < 2; ++i) { stage_rc(tid * 16 + i * 8192, R[i], C[i]); Rp[i] = (R[i] & ~31) + perm32(R[i] & 31); }
    }
};
template <class Epi, class Sched, bool ALIGN_EPI>
__device__ __forceinline__ void gemm_phase(LAS unsigned char* lds, const Sched& S, const Epi& E) {
    int tid = threadIdx.x; asm volatile("" : "+v"(tid));
    const int wid = __builtin_amdgcn_readfirstlane(tid >> 6), lane = tid & 63, wr = wid >> 2, wc = wid & 3, fr = lane & 15, fq = lane >> 4;
    const unsigned ldsw = (unsigned)wid * 1024u;
    const int aoff = lds_byte(wr * 64 + fr, fq * 8), boff = lds_byte(wc * 32 + fr, fq * 8);
#define PG8_SA(b, h) (((b) * 2 + (h)) * HTB)
#define PG8_SB(b, h) ((4 + (b) * 2 + (h)) * HTB)
#define PG8_STAGE(bufoff, gbase, voff) do { _Pragma("unroll") for (int _i = 0; _i < 2; ++_i) \
        __builtin_amdgcn_global_load_lds((const unsigned*)((const char*)(gbase) + (voff)[_i]), (LAS unsigned*)(lds + (bufoff) + ldsw + _i * 8192), 16, 0, 0); } while (0)
#define PG8_LDA(dst, b, h) do { _Pragma("unroll") for (int m = 0; m < 4; ++m) _Pragma("unroll") for (int k = 0; k < 2; ++k) dst[m][k] = *(const LAS bf16x8*)(lds + PG8_SA(b, h) + aoff + m * 2048 + k * 1024); } while (0)
#define PG8_LDB(dst, b, h) do { _Pragma("unroll") for (int n = 0; n < 2; ++n) _Pragma("unroll") for (int k = 0; k < 2; ++k) dst[n][k] = *(const LAS bf16x8*)(lds + PG8_SB(b, h) + boff + n * 2048 + k * 1024); } while (0)
#define PG8_MMA(ai, bj, At, Bt) do { __builtin_amdgcn_s_setprio(1); _Pragma("unroll") for (int m = 0; m < 4; ++m) _Pragma("unroll") for (int n = 0; n < 2; ++n) _Pragma("unroll") for (int k = 0; k < 2; ++k) \
        acc[ai][bj][m][n] = __builtin_amdgcn_mfma_f32_16x16x32_bf16(Bt[n][k], At[m][k], acc[ai][bj][m][n], 0, 0, 0); __builtin_amdgcn_s_setprio(0); } while (0)
#define PG8_WAIT_V(n) asm volatile("s_waitcnt vmcnt(" #n ")" ::: "memory")
#define PG8_WAIT_L(n) asm volatile("s_waitcnt lgkmcnt(" #n ")" ::: "memory")
#define PG8_BAR __builtin_amdgcn_s_barrier()
#define PG8_SCHED __builtin_amdgcn_sched_barrier(0)
    GUnit cur, nxt; int ui = 0;
    if (!S.next(0, cur)) return;
    f32x4 acc[2][2][4][2];
#pragma unroll
    for (int a = 0; a < 2; ++a)
#pragma unroll
        for (int b = 0; b < 2; ++b)
#pragma unroll
            for (int m = 0; m < 4; ++m)
#pragma unroll
                for (int n = 0; n < 2; ++n) acc[a][b][m][n] = (f32x4){0.f, 0.f, 0.f, 0.f};
    bf16x8 At[4][2], B0[2][2], B1[2][2];
    constexpr bool GA = Sched::GATHER;
#define PG8_STA(bufoff, U, h, koff) do { if constexpr (GA) { if ((h) == 0) PG8_STAGE(bufoff, (U).a + (koff), (U).offA); else PG8_STAGE(bufoff, (U).a + (koff), (U).offA1); } \
        else PG8_STAGE(bufoff, (U).a + (koff) + (size_t)((h) * (U).hsA), (U).offA); } while (0)
#define PG8_STB(bufoff, U, h, koff) PG8_STAGE(bufoff, (U).b + (koff) + (size_t)((h) * (U).hsB), (U).offB)
    PG8_STB(PG8_SB(0, 0), cur, 0, 0); PG8_STB(PG8_SB(0, 1), cur, 1, 0); PG8_STA(PG8_SA(0, 0), cur, 0, 0); PG8_STA(PG8_SA(0, 1), cur, 1, 0);
    if (wr == 1) PG8_BAR;
    PG8_WAIT_V(2); PG8_BAR;
    PG8_STB(PG8_SB(1, 0), cur, 0, 128); PG8_STA(PG8_SA(1, 0), cur, 0, 128); PG8_STB(PG8_SB(1, 1), cur, 1, 128);
    PG8_WAIT_V(6); PG8_BAR;
    for (;;) {
        const bool has_next = S.next(ui + 1, nxt);
        if (!has_next) nxt = cur;
        const int nt = cur.nt;
        for (int t = 0; t < nt; t += 2) {
            const bool last = (t == nt - 2);
            const size_t k1 = (size_t)(t + 1) * 128;
            GUnit sel;
            sel.a = last ? nxt.a : cur.a + (size_t)(t + 2) * 128; sel.b = last ? nxt.b : cur.b + (size_t)(t + 2) * 128;
            sel.hsA = last ? nxt.hsA : cur.hsA; sel.hsB = last ? nxt.hsB : cur.hsB;
#pragma unroll
            for (int i = 0; i < 2; ++i) { sel.offA[i] = last ? nxt.offA[i] : cur.offA[i]; sel.offB[i] = last ? nxt.offB[i] : cur.offB[i]; if constexpr (GA) sel.offA1[i] = last ? nxt.offA1[i] : cur.offA1[i]; }
            PG8_LDB(B0, 0, 0); PG8_LDB(B1, 0, 1); PG8_SCHED; PG8_LDA(At, 0, 0); PG8_STA(PG8_SA(1, 1), cur, 1, k1);
            PG8_WAIT_V(8); PG8_WAIT_L(0); PG8_BAR; PG8_MMA(0, 0, At, B0); PG8_MMA(0, 1, At, B1); PG8_BAR; PG8_SCHED;
            PG8_LDA(At, 0, 1); PG8_STB(PG8_SB(0, 0), sel, 0, 0); PG8_STB(PG8_SB(0, 1), sel, 1, 0); PG8_STA(PG8_SA(0, 0), sel, 0, 0);
            PG8_WAIT_V(8); PG8_WAIT_L(0); PG8_BAR; PG8_MMA(1, 0, At, B0); PG8_MMA(1, 1, At, B1); PG8_BAR; PG8_SCHED;
            PG8_LDB(B0, 1, 0); PG8_LDB(B1, 1, 1); PG8_SCHED; PG8_LDA(At, 1, 0); PG8_STA(PG8_SA(0, 1), sel, 1, 0);
            PG8_WAIT_V(8); PG8_WAIT_L(0); PG8_BAR; PG8_MMA(0, 0, At, B0); PG8_MMA(0, 1, At, B1); PG8_BAR; PG8_SCHED;
            PG8_LDA(At, 1, 1); PG8_STB(PG8_SB(1, 0), sel, 0, 128); PG8_STB(PG8_SB(1, 1), sel, 1, 128); PG8_STA(PG8_SA(1, 0), sel, 0, 128);
            PG8_WAIT_V(8); PG8_WAIT_L(0); PG8_BAR; PG8_MMA(1, 0, At, B0); PG8_MMA(1, 1, At, B1); PG8_BAR; PG8_SCHED;
        }
        if constexpr (ALIGN_EPI) { if (wr == 0) PG8_BAR; }
        E(acc, cur, wr, wc, fr, fq);
        if (!has_next) break;
#pragma unroll
        for (int a = 0; a < 2; ++a)
#pragma unroll
            for (int b = 0; b < 2; ++b)
#pragma unroll
                for (int m = 0; m < 4; ++m)
#pragma unroll
                    for (int n = 0; n < 2; ++n) acc[a][b][m][n] = (f32x4){0.f, 0.f, 0.f, 0.f};
        cur = nxt; ++ui;
        if constexpr (ALIGN_EPI) { if (wr == 1) PG8_BAR; }
    }
    PG8_WAIT_V(0);
    if constexpr (!ALIGN_EPI) { if (wr == 0) PG8_BAR; }
    PG8_BAR;
#undef PG8_SA
#undef PG8_SB
#undef PG8_STAGE
#undef PG8_STA
#undef PG8_STB
#undef PG8_LDA
#undef PG8_LDB
#undef PG8_MMA
#undef PG8_WAIT_V
#undef PG8_WAIT_L
#undef PG8_BAR
#undef PG8_SCHED
}

__device__ __forceinline__ void tile_of(int wgid, int nM, int nN, int& pm, int& pn) {
    const int WGM = 8, nig = WGM * nN, gid = wgid / nig, fm = gid * WGM, gsz = (nM - fm) < WGM ? (nM - fm) : WGM;
    pm = fm + ((wgid % nig) % gsz); pn = (wgid % nig) / gsz;
}
__device__ __forceinline__ void dense_offsets(GUnit& u, const LaneGeom& g, int lda_bytes, int ldb_bytes, bool perm) {
    u.hsA = 128 * lda_bytes; u.hsB = 128 * ldb_bytes;
#pragma unroll
    for (int i = 0; i < 2; ++i) {
        u.offA[i] = (unsigned)(g.R[i] * lda_bytes + g.C[i] * 2); u.offA1[i] = 0u;
        u.offB[i] = (unsigned)((perm ? g.Rp[i] : g.R[i]) * ldb_bytes + g.C[i] * 2);
    }
}
}
using pg8::GUnit; using pg8::LaneGeom;

struct Params {
    const float* x; const float* mem; const int* positions;
    const float* w_in; const float* w_mem_kv; const float* w_gate; const float* b_gate;
    const float* w_br_dil; const float* w_br_moba; const float* w_br_mem; const float* w_out;
    const float* ln1_g; const float* ln1_b; const float* w_router; const float* router_bias;
    const float* w_e_gate; const float* w_e_up; const float* w_e_down;
    const float* w_s_gate; const float* w_s_up; const float* w_s_down; const float* ln2_g; const float* ln2_b;
    float* out; unsigned char* ws;
};

__device__ __forceinline__ void transpose_item(const float* W, int N, bf16_t* WT, int dld, int k0, int n0, int drow0, LAS float* scr, int lane) {
#pragma unroll 8
    for (int i = 0; i < 32; ++i) { const int kk = 2 * i + (lane >> 5); scr[kk * 33 + (lane & 31)] = W[(size_t)(k0 + kk) * N + n0 + (lane & 31)]; }
    LDS_WAIT(); asm volatile("" ::: "memory");
    const int c = lane & 7;
#pragma unroll
    for (int j = 0; j < 4; ++j) { const int n = (lane >> 3) + 8 * j; const LAS float* s = scr + (8 * c) * 33 + n;
        u32x4 o; o.x = cvtpk(s[0 * 33], s[1 * 33]); o.y = cvtpk(s[2 * 33], s[3 * 33]); o.z = cvtpk(s[4 * 33], s[5 * 33]); o.w = cvtpk(s[6 * 33], s[7 * 33]);
        *(u32x4*)(WT + (size_t)(drow0 + n) * dld + k0 + 8 * c) = o; }
    LDS_WAIT(); asm volatile("" ::: "memory");
}
__device__ __forceinline__ bool p0_seg(int& r, const float* W, int K, int N, bf16_t* WT, int dld, int mode  , int row_off, LAS float* scr, int lane) {
    const int nblk = N / 32, items = (K / 64) * nblk;
    if (r >= items) { r -= items; return false; }
    const int kb = r / nblk, nb = r % nblk, n0 = 32 * nb;
    const int drow0 = row_off + (mode == 0 ? n0 : 256 * (n0 >> 7) + (n0 & 127) + (mode == 2 ? 128 : 0));
    transpose_item(W, N, WT, dld, 64 * kb, n0, drow0, scr, lane);
    return true;
}
__device__ __forceinline__ void p0_prologue(const Params& P, LAS unsigned char* lds, int gw, int NGW, int gtid, int NTHR, int lane, int wave) {
    unsigned char* ws = P.ws;
    LAS float* scr = (LAS float*)(lds + wave * 16384);
    constexpr int SMALL_ITEMS = 1280 + 1536 + 256 + 64 + 192 + 128 + 512 + 128 + 128 + 128 + 128;
    constexpr int EXP_ITEMS = 128;
    constexpr int NITEMS = SMALL_ITEMS + 3 * NEXP * EXP_ITEMS;
    for (int it = gw; it < NITEMS; it += NGW) {
        int r = it;
        if (r < SMALL_ITEMS) {
            if (p0_seg(r, P.w_in, 1024, WIN, (bf16_t*)(ws + WS_WTQG), 1024, 0, 0, scr, lane)) continue;
            if (p0_seg(r, P.w_gate, 1024, NGATE, (bf16_t*)(ws + WS_WTQG), 1024, 0, WIN, scr, lane)) continue;
            if (p0_seg(r, P.w_mem_kv, 1024, 512, (bf16_t*)(ws + WS_WTKV), 1024, 0, 0, scr, lane)) continue;
            if (p0_seg(r, P.w_br_dil, 128, 1024, (bf16_t*)(ws + WS_WTBRD), 128, 0, 0, scr, lane)) continue;
            if (p0_seg(r, P.w_br_moba, 384, 1024, (bf16_t*)(ws + WS_WTBRM), 384, 0, 0, scr, lane)) continue;
            if (p0_seg(r, P.w_br_mem, 256, 1024, (bf16_t*)(ws + WS_WTBRX), 256, 0, 0, scr, lane)) continue;
            if (p0_seg(r, P.w_out, 1024, 1024, (bf16_t*)(ws + WS_WTOUT), 1024, 0, 0, scr, lane)) continue;
            if (p0_seg(r, P.w_router, 1024, 256, (bf16_t*)(ws + WS_WTRS), 1024, 0, 0, scr, lane)) continue;
            if (p0_seg(r, P.w_s_gate, 1024, 256, (bf16_t*)(ws + WS_WTRS), 1024, 1, 256, scr, lane)) continue;
            if (p0_seg(r, P.w_s_up, 1024, 256, (bf16_t*)(ws + WS_WTRS), 1024, 2, 256, scr, lane)) continue;
            p0_seg(r, P.w_s_down, 256, 1024, (bf16_t*)(ws + WS_WTSD), 256, 0, 0, scr, lane);
        } else {
            r -= SMALL_ITEMS;
            const int which = r / (NEXP * EXP_ITEMS); r -= which * (NEXP * EXP_ITEMS);
            const int e = r / EXP_ITEMS; r -= e * EXP_ITEMS;
            if (which == 0) p0_seg(r, P.w_e_gate + (size_t)e * 1024 * 256, 1024, 256, (bf16_t*)(ws + WS_W1T) + (size_t)e * 512 * 1024, 1024, 1, 0, scr, lane);
            else if (which == 1) p0_seg(r, P.w_e_up + (size_t)e * 1024 * 256, 1024, 256, (bf16_t*)(ws + WS_W1T) + (size_t)e * 512 * 1024, 1024, 2, 0, scr, lane);
            else p0_seg(r, P.w_e_down + (size_t)e * 256 * 1024, 256, 1024, (bf16_t*)(ws + WS_W2T) + (size_t)e * 1024 * 256, 256, 0, 0, scr, lane);
        }
    }
    for (int c = gtid; c < NTOK * DM / 8; c += NTHR) { const f32x4 a = *(const f32x4*)(P.x + (size_t)c * 8), b = *(const f32x4*)(P.x + (size_t)c * 8 + 4); *(u32x4*)((bf16_t*)(ws + WS_XB) + (size_t)c * 8) = pack8(a, b); }
    for (int c = gtid; c < 2048 * DM / 8; c += NTHR) { const f32x4 a = *(const f32x4*)(P.mem + (size_t)c * 8), b = *(const f32x4*)(P.mem + (size_t)c * 8 + 4); *(u32x4*)((bf16_t*)(ws + WS_MEMB) + (size_t)c * 8) = pack8(a, b); }
    for (int tkn = gtid; tkn < NTOK; tkn += NTHR) {
        const double p = (double)P.positions[tkn]; float* o = (float*)(ws + WS_ROPE) + (size_t)tkn * 16;
#define ROPE_J(j, f) { const double a = p * (double)(f); const double rv = a * 0.15915494309189535; const double fr_ = rv - __builtin_rint(rv); const float ang = (float)(fr_ * 6.283185307179586); o[j] = cosf(ang); o[8 + j] = sinf(ang); }
        ROPE_J(0, 1.0f) ROPE_J(1, 0.1939227432012558f) ROPE_J(2, 0.03760603070259094f) ROPE_J(3, 0.007292664609849453f)
        ROPE_J(4, 0.0014142135623842478f) ROPE_J(5, 0.00027424818836152554f) ROPE_J(6, 5.318296098266728e-05f) ROPE_J(7, 1.0313386155758053e-05f)
#undef ROPE_J
    }
    unsigned* ctl = (unsigned*)(ws + WS_CTL);
    for (int i = gtid; i < 8192 + 49152; i += NTHR) ctl[i] = 0u;
}

struct SchedP1 {
    static constexpr bool GATHER = false;
    LaneGeom g; int G, c; const unsigned char* ws;
    __device__ __forceinline__ bool next(int i, GUnit& u) const {
        const int L = i * G + c; if (L >= 2816 + 16) return false;
        if (L < 2816) { const int wgid = pg8::xcd_remap(L, 2816); pg8::tile_of(wgid, 128, 22, u.pm, u.pn);
            u.a = (const char*)(ws + WS_XB) + (size_t)u.pm * 256 * 2048; u.b = (const char*)(ws + WS_WTQG) + (size_t)u.pn * 256 * 2048; u.kind = u.pn < 10 ? 0 : 1; }
        else { const int j = L - 2816; u.pm = j >> 1; u.pn = j & 1; u.kind = 2;
            u.a = (const char*)(ws + WS_MEMB) + (size_t)u.pm * 256 * 2048; u.b = (const char*)(ws + WS_WTKV) + (size_t)u.pn * 256 * 2048; }
        u.nt = 16; u.aux = 0; pg8::dense_offsets(u, g, 2048, 2048, true); return true;
    }
};
struct EpiP1 {
    bf16_t* qkv; bf16_t* gates; bf16_t* kvm; const float* bgate; const float* rope; float* ksum;
    __device__ __forceinline__ void operator()(const f32x4 (&acc)[2][2][4][2], const GUnit& u, int wr, int wc, int fr, int fq) const {
        const int row0 = u.pm * 256 + wr * 64 + fr;
        if (u.kind == 0) {
#pragma unroll
            for (int bj = 0; bj < 2; ++bj) {
                const int colbase = u.pn * 256 + 128 * bj + 32 * wc, head = colbase >> 6;
                const bool rope_head = head < 12 || (head >= 18 && head < 30);
                const bool rot = rope_head && ((colbase & 63) == 0);
                const bool qhead = head < 6 || (head >= 18 && head < 24) || head >= 36;
                const bool khead = head >= 24 && head < 30;
                const float sc = qhead ? C2 : 1.0f;
                f32x4 cs0 = {0.f, 0.f, 0.f, 0.f}, cs1 = {0.f, 0.f, 0.f, 0.f};
#pragma unroll
                for (int ai = 0; ai < 2; ++ai)
#pragma unroll
                    for (int m = 0; m < 4; ++m) {
                        const int row = row0 + 128 * ai + 16 * m;
                        f32x4 v0 = acc[ai][bj][m][0], v1 = acc[ai][bj][m][1];
                        if (rot) {
                            f32x4 p0, p1;
#pragma unroll
                            for (int e = 0; e < 4; ++e) { p0[e] = __shfl_xor(v0[e], 16); p1[e] = __shfl_xor(v1[e], 16); }
                            const float* rp = rope + (size_t)row * 16;
                            const f32x4 c0 = *(const f32x4*)(rp), c1 = *(const f32x4*)(rp + 4), s0 = *(const f32x4*)(rp + 8), s1 = *(const f32x4*)(rp + 12);
                            if (fq == 0) { v0 = v0 * c0 - p0 * s0; v1 = v1 * c1 - p1 * s1; }
                            else if (fq == 1) { v0 = v0 * c0 + p0 * s0; v1 = v1 * c1 + p1 * s1; }
                        }
                        v0 = v0 * sc; v1 = v1 * sc;
                        if (khead) { cs0 += v0; cs1 += v1; }
                        *(u32x4*)(qkv + (size_t)row * WIN + colbase + 8 * fq) = pack8(v0, v1);
                    }
                if (khead) {
#pragma unroll
                    for (int e = 0; e < 4; ++e) {
#pragma unroll
                        for (int o = 1; o < 16; o <<= 1) { cs0[e] += __shfl_xor(cs0[e], o); cs1[e] += __shfl_xor(cs1[e], o); }
                    }
                    if (fr == 0) { float* kp = ksum + ((size_t)u.pm * 6 + (head - 24)) * 64 + (colbase & 63) + 8 * fq;
#pragma unroll
                        for (int e = 0; e < 4; ++e) { atomicAdd(kp + e, cs0[e]); atomicAdd(kp + 4 + e, cs1[e]); } }
                }
            }
        } else if (u.kind == 1) {
#pragma unroll
            for (int bj = 0; bj < 2; ++bj) {
                const int col = (u.pn - 10) * 256 + 128 * bj + 32 * wc + 8 * fq;
                const f32x4 b0 = *(const f32x4*)(bgate + col), b1 = *(const f32x4*)(bgate + col + 4);
#pragma unroll
                for (int ai = 0; ai < 2; ++ai)
#pragma unroll
                    for (int m = 0; m < 4; ++m) {
                        const int row = row0 + 128 * ai + 16 * m;
                        f32x4 v0 = acc[ai][bj][m][0] + b0, v1 = acc[ai][bj][m][1] + b1;
#pragma unroll
                        for (int e = 0; e < 4; ++e) { v0[e] = fast_sigmoid(v0[e]); v1[e] = fast_sigmoid(v1[e]); }
                        *(u32x4*)(gates + (size_t)row * NGATE + col) = pack8(v0, v1);
                    }
            }
        } else {
#pragma unroll
            for (int bj = 0; bj < 2; ++bj) {
                const int col = u.pn * 256 + 128 * bj + 32 * wc + 8 * fq;
#pragma unroll
                for (int ai = 0; ai < 2; ++ai)
#pragma unroll
                    for (int m = 0; m < 4; ++m) { const int row = row0 + 128 * ai + 16 * m; *(u32x4*)(kvm + (size_t)row * 512 + col) = pack8(acc[ai][bj][m][0], acc[ai][bj][m][1]); }
            }
        }
    }
};

struct SchedP3 {
    static constexpr bool GATHER = false;
    LaneGeom g; int G, c; const unsigned char* ws;
    __device__ __forceinline__ bool next(int i, GUnit& u) const {
        const int i3 = i / 3, br = i - 3 * i3; const int L = i3 * G + c; if (L >= 512) return false;
        const int wgid = pg8::xcd_remap(L, 512); pg8::tile_of(wgid, 128, 4, u.pm, u.pn);
        u.kind = br; u.aux = 0;
        int kb; size_t abase, bbase;
        if (br == 0) { kb = 128; abase = WS_YDIL; bbase = WS_WTBRD; } else if (br == 1) { kb = 384; abase = WS_YMOBA; bbase = WS_WTBRM; } else { kb = 256; abase = WS_YMEM; bbase = WS_WTBRX; }
        u.nt = kb / 64;
        u.a = (const char*)(ws + abase) + (size_t)u.pm * 256 * kb * 2; u.b = (const char*)(ws + bbase) + (size_t)u.pn * 256 * kb * 2;
        pg8::dense_offsets(u, g, kb * 2, kb * 2, true); return true;
    }
};
struct EpiP3 {
    const bf16_t* gates; bf16_t* merged;
    __device__ __forceinline__ void operator()(const f32x4 (&acc)[2][2][4][2], const GUnit& u, int wr, int wc, int fr, int fq) const {
        const int row0 = u.pm * 256 + wr * 64 + fr;
#pragma unroll
        for (int ai = 0; ai < 2; ++ai)
#pragma unroll
            for (int m = 0; m < 4; ++m) {
                const int row = row0 + 128 * ai + 16 * m;
#pragma unroll
                for (int bj = 0; bj < 2; ++bj) {
                    const int col = u.pn * 256 + 128 * bj + 32 * wc + 8 * fq;
                    f32x4 g0, g1; unpack8(*(const u32x4*)(gates + (size_t)row * NGATE + u.kind * 1024 + col), g0, g1);
                    f32x4 v0 = g0 * acc[ai][bj][m][0], v1 = g1 * acc[ai][bj][m][1];
                    bf16_t* mp = merged + (size_t)row * DM + col;
                    if (u.kind != 0) { f32x4 o0, o1; unpack8(*(const u32x4*)mp, o0, o1); v0 += o0; v1 += o1; }
                    *(u32x4*)mp = pack8(v0, v1);
                }
            }
    }
};

struct SchedP4 {
    static constexpr bool GATHER = false;
    LaneGeom g; int G, c; const unsigned char* ws;
    __device__ __forceinline__ bool next(int i, GUnit& u) const {
        const int L = i * G + c; if (L >= 512) return false;
        const int wgid = pg8::xcd_remap(L, 512); pg8::tile_of(wgid, 128, 4, u.pm, u.pn);
        u.kind = 0; u.aux = 0; u.nt = 16;
        u.a = (const char*)(ws + WS_MERGED) + (size_t)u.pm * 256 * 2048; u.b = (const char*)(ws + WS_WTOUT) + (size_t)u.pn * 256 * 2048;
        pg8::dense_offsets(u, g, 2048, 2048, false); return true;
    }
};
struct EpiP4 {
    const float* x; float* h1;
    __device__ __forceinline__ void operator()(const f32x4 (&acc)[2][2][4][2], const GUnit& u, int wr, int wc, int fr, int fq) const {
        const int row0 = u.pm * 256 + wr * 64 + fr, col0 = u.pn * 256 + wc * 32 + 4 * fq;
#pragma unroll
        for (int ai = 0; ai < 2; ++ai)
#pragma unroll
            for (int m = 0; m < 4; ++m) { const size_t off = (size_t)(row0 + 128 * ai + 16 * m) * DM + col0;
#pragma unroll
                for (int bj = 0; bj < 2; ++bj)
#pragma unroll
                    for (int n = 0; n < 2; ++n) { const f32x4 xv = *(const f32x4*)(x + off + bj * 128 + n * 16); *(f32x4*)(h1 + off + bj * 128 + n * 16) = xv * ALPHA + acc[ai][bj][m][n]; } }
    }
};

struct SchedP6 {
    static constexpr bool GATHER = false;
    LaneGeom g; int G, c; const unsigned char* ws;
    __device__ __forceinline__ bool next(int i, GUnit& u) const {
        const int L = i * G + c; if (L >= 384) return false;
        const int wgid = pg8::xcd_remap(L, 384); pg8::tile_of(wgid, 128, 3, u.pm, u.pn);
        u.kind = u.pn == 0 ? 0 : 1; u.aux = 0; u.nt = 16;
        u.a = (const char*)(ws + WS_X1B) + (size_t)u.pm * 256 * 2048; u.b = (const char*)(ws + WS_WTRS) + (size_t)u.pn * 256 * 2048;
        pg8::dense_offsets(u, g, 2048, 2048, u.pn != 0); return true;
    }
};
__device__ __forceinline__ void swiglu_store(const f32x4 (&acc)[2][2][4][2], bf16_t* hid, size_t row_base  , int hcol0, int wr, int wc, int fr, int fq) {
#pragma unroll
    for (int ai = 0; ai < 2; ++ai)
#pragma unroll
        for (int m = 0; m < 4; ++m) {
            const size_t row = row_base + 128 * ai + 64 * wr + 16 * m + fr;
            f32x4 h0, h1;
#pragma unroll
            for (int e = 0; e < 4; ++e) { const float g0 = acc[ai][0][m][0][e], g1 = acc[ai][0][m][1][e];
                h0[e] = g0 * fast_sigmoid(g0) * acc[ai][1][m][0][e]; h1[e] = g1 * fast_sigmoid(g1) * acc[ai][1][m][1][e]; }
            *(u32x4*)(hid + row * 256 + hcol0 + 32 * wc + 8 * fq) = pack8(h0, h1);
        }
}
struct EpiP6 {
    float* scores; bf16_t* hids;
    __device__ __forceinline__ void operator()(const f32x4 (&acc)[2][2][4][2], const GUnit& u, int wr, int wc, int fr, int fq) const {
        if (u.kind == 0) {
            const int row0 = u.pm * 256 + wr * 64 + fr, col0 = wc * 32 + 4 * fq;
#pragma unroll
            for (int ai = 0; ai < 2; ++ai)
#pragma unroll
                for (int m = 0; m < 4; ++m) { const size_t off = (size_t)(row0 + 128 * ai + 16 * m) * 256 + col0;
#pragma unroll
                    for (int bj = 0; bj < 2; ++bj)
#pragma unroll
                        for (int n = 0; n < 2; ++n) { f32x4 v = acc[ai][bj][m][n];
#pragma unroll
                            for (int e = 0; e < 4; ++e) v[e] = 1.0f / (1.0f + __expf(-v[e]));
                            *(f32x4*)(scores + off + bj * 128 + n * 16) = v; } }
        } else swiglu_store(acc, hids, (size_t)u.pm * 256, 128 * (u.pn - 1), wr, wc, fr, fq);
    }
};

struct SchedP9 {
    static constexpr bool GATHER = true;
    LaneGeom g; int G, c; const unsigned char* ws; int nwg;
    __device__ __forceinline__ bool next(int i, GUnit& u) const {
        const int L = i * G + c; if (L >= nwg) return false;
        const int wgid = pg8::xcd_remap(L, nwg); const int rt = wgid >> 1, p = wgid & 1;
        const int e = ((const int*)(ws + WS_CTL))[CW_TILEE + rt];
        u.pm = rt; u.pn = p; u.kind = 0; u.aux = e; u.nt = 16;
        u.a = (const char*)(ws + WS_X1B); u.b = (const char*)(ws + WS_W1T) + (size_t)e * (512 * 2048) + (size_t)p * 256 * 2048;
        const int* rtok = (const int*)(ws + WS_ROWTOK) + (size_t)rt * 256;
        u.hsA = 0; u.hsB = 128 * 2048;
#pragma unroll
        for (int k = 0; k < 2; ++k) { u.offA[k] = (unsigned)rtok[g.R[k]] * 2048u + (unsigned)(g.C[k] * 2); u.offA1[k] = (unsigned)rtok[128 + g.R[k]] * 2048u + (unsigned)(g.C[k] * 2); u.offB[k] = (unsigned)(g.Rp[k] * 2048 + g.C[k] * 2); }
        return true;
    }
};
struct EpiP9 {
    bf16_t* hid;
    __device__ __forceinline__ void operator()(const f32x4 (&acc)[2][2][4][2], const GUnit& u, int wr, int wc, int fr, int fq) const { swiglu_store(acc, hid, (size_t)u.pm * 256, 128 * u.pn, wr, wc, fr, fq); }
};

__device__ __forceinline__ bf16_t* y_row(unsigned char* ws, int r) { return r < Y_SPLIT ? (bf16_t*)(ws + WS_Y1) + (size_t)r * DM : (bf16_t*)(ws + WS_Y2) + (size_t)(r - Y_SPLIT) * DM; }
struct SchedP10 {
    static constexpr bool GATHER = false;
    LaneGeom g; int G, c; const unsigned char* ws; int nwg;
    __device__ __forceinline__ bool next(int i, GUnit& u) const {
        const int L = i * G + c; if (L >= nwg) return false;
        u.nt = 4; u.aux = 0;
        const int wgid = pg8::xcd_remap(L, nwg); const int rt = wgid >> 2, pn = wgid & 3;
        const int e = ((const int*)(ws + WS_CTL))[CW_TILEE + rt];
        u.pm = rt; u.pn = pn; u.kind = 0;
        u.a = (const char*)(ws + WS_HID) + (size_t)rt * 256 * 512; u.b = (const char*)(ws + WS_W2T) + (size_t)e * (1024 * 512) + (size_t)pn * 256 * 512;
        pg8::dense_offsets(u, g, 512, 512, true);
        return true;
    }
};
struct EpiP10 {
    unsigned char* ws; const int* row_y; const float* row_w;
    __device__ __forceinline__ void operator()(const f32x4 (&acc)[2][2][4][2], const GUnit& u, int wr, int wc, int fr, int fq) const {
#pragma unroll
        for (int ai = 0; ai < 2; ++ai)
#pragma unroll
            for (int m = 0; m < 4; ++m) {
                const int d = u.pm * 256 + 128 * ai + 64 * wr + 16 * m + fr;
                const int ry = row_y[d]; const float w = row_w[d];
                if (ry >= 0) { bf16_t* yp = y_row(ws, ry) + u.pn * 256 + 32 * wc + 8 * fq;
#pragma unroll
                    for (int bj = 0; bj < 2; ++bj) *(u32x4*)(yp + 128 * bj) = pack8(acc[ai][bj][m][0] * w, acc[ai][bj][m][1] * w); }
            }
    }
};
struct SchedP10s {
    static constexpr bool GATHER = false;
    LaneGeom g; int G, c; const unsigned char* ws; int shift;
    __device__ __forceinline__ bool next(int i, GUnit& u) const {
        const int L = i * G + ((c + shift) % G); if (L >= 512) return false;
        u.nt = 4; u.aux = 0; u.kind = 1;
        const int wgid = pg8::xcd_remap(L, 512); pg8::tile_of(wgid, 128, 4, u.pm, u.pn);
        u.a = (const char*)(ws + WS_HIDS) + (size_t)u.pm * 256 * 512; u.b = (const char*)(ws + WS_WTSD) + (size_t)u.pn * 256 * 512;
        pg8::dense_offsets(u, g, 512, 512, false);
        return true;
    }
};
struct EpiP10s {
    float* x1f;
    __device__ __forceinline__ void operator()(const f32x4 (&acc)[2][2][4][2], const GUnit& u, int wr, int wc, int fr, int fq) const {
        const int row0 = u.pm * 256 + wr * 64 + fr, col0 = u.pn * 256 + wc * 32 + 4 * fq;
#pragma unroll
        for (int ai = 0; ai < 2; ++ai)
#pragma unroll
            for (int m = 0; m < 4; ++m) { const size_t off = (size_t)(row0 + 128 * ai + 16 * m) * DM + col0;
#pragma unroll
                for (int bj = 0; bj < 2; ++bj)
#pragma unroll
                    for (int n = 0; n < 2; ++n) { float* p = x1f + off + bj * 128 + n * 16; const f32x4 xv = *(const f32x4*)p; *(f32x4*)p = xv * ALPHA + acc[ai][bj][m][n]; } }
    }
};

namespace att {
constexpr int SLOTB = 8192, LDS_K = 0, LDS_V = 2 * SLOTB, LDS_WS = 4 * SLOTB, LDS_OST = LDS_WS + 8 * 256, LDS_BYTES = LDS_OST + 8 * 4096;
typedef short v4i16_t __attribute__((ext_vector_type(4)));
__device__ __forceinline__ int crow(int r, int hi) { return (r & 3) + 8 * (r >> 2) + 4 * hi; }
__device__ __forceinline__ void glds16(const void* gsrc, unsigned lds_dst) { unsigned keep;
    asm volatile("s_mov_b32 %0, m0\n\ts_mov_b32 m0, %2\n\ts_nop 0\n\tglobal_load_lds_dwordx4 %1, off\n\ts_mov_b32 m0, %0" : "=&s"(keep) : "v"(gsrc), "s"(lds_dst) : "memory"); }
__device__ __forceinline__ s16x4 vtr(LAS const char* p) { return __builtin_bit_cast(s16x4, __builtin_amdgcn_ds_read_tr16_b64_v4i16((LAS v4i16_t*)p)); }
__device__ __forceinline__ float rowmax32(const f32x16& p0, const f32x16& p1) {
    float a = p0[0];
#pragma unroll
    for (int r = 1; r < 16; ++r) a = __builtin_fmaxf(a, p0[r]);
#pragma unroll
    for (int r = 0; r < 16; ++r) a = __builtin_fmaxf(a, p1[r]);
    auto rr = __builtin_amdgcn_permlane32_swap(__float_as_uint(a), __float_as_uint(a), false, false);
    return __builtin_fmaxf(__uint_as_float(rr[0]), __uint_as_float(rr[1]));
}
struct Desc {
    const bf16_t* q; long qs;
    const bf16_t* k; const bf16_t* v; long kvs; int key0;
    bf16_t* o; long os;
    float* lse; long lses;
    int nt;
    int mode;
    int qb;
    const float* ksum;
};
template <int MODE>
__device__ __forceinline__ void attn_unit(LAS char* shm, const Desc& D) {
    int tid = threadIdx.x; asm volatile("" : "+v"(tid));
    const int lane = tid & 63, r32 = lane & 31, hi = lane >> 5; const int wid = __builtin_amdgcn_readfirstlane(tid >> 6);
    const unsigned lds0 = (unsigned)(uintptr_t)shm;
    LAS float* wsf = (LAS float*)(shm + LDS_WS) + wid * 64;
    const bf16_t* Qw = D.q + (long)(wid * 32 + r32) * D.qs;
    bf16x8 qr[4];
#pragma unroll
    for (int d0 = 0; d0 < 4; ++d0) qr[d0] = *(const bf16x8*)(Qw + d0 * 16 + hi * 8);
    unsigned selmask = 0u;
    if constexpr (MODE == 1) {
        f32x16 gacc = {};
        const int n = lane & 31;
#pragma unroll
        for (int d0 = 0; d0 < 4; ++d0) {
            bf16x8 a = {};
            if (n < 16) { const float* kp = D.ksum + (size_t)n * (6 * 64) + 16 * d0 + 8 * hi; const f32x4 x0 = *(const f32x4*)kp, x1 = *(const f32x4*)(kp + 4); a = __builtin_bit_cast(bf16x8, pack8(x0 * (1.0f / 256.0f), x1 * (1.0f / 256.0f))); }
            gacc = __builtin_amdgcn_mfma_f32_32x32x16_bf16(a, qr[d0], gacc, 0, 0, 0);
        }
        float cv[16]; int cn[16];
#pragma unroll
        for (int r = 0; r < 8; ++r) { cv[r] = gacc[r]; cn[r] = crow(r, hi); cv[8 + r] = __shfl_xor(gacc[r], 32); cn[8 + r] = crow(r, hi ^ 1); }
#pragma unroll
        for (int rep = 0; rep < 3; ++rep) {
            float best = NEG_INF; int bi = -1;
#pragma unroll
            for (int c = 0; c < 16; ++c) { const bool ok = cn[c] < D.qb && !((selmask >> cn[c]) & 1u); const bool better = ok && (bi < 0 || cv[c] > best || (cv[c] == best && cn[c] < bi)); if (better) { best = cv[c]; bi = cn[c]; } }
            if (bi >= 0) selmask |= 1u << bi;
        }
    }
    float mrun = NEG_INF, lrun = 0.f; f32x16 o[2]; o[0] = f32x16{}; o[1] = f32x16{};
    const int NT = D.nt;
    const LAS char* kp0 = (const LAS char*)shm + LDS_K + hi * 1024 + r32 * 16;
    const LAS char* vp0 = (const LAS char*)shm + LDS_V + ((lane >> 4) & 1) * 32 + (lane & 3) * 8 + (4 * hi + ((lane & 15) >> 2)) * 64;
    auto ktile = [&](int t) -> int { if constexpr (MODE == 1) return t < 4 ? (NT - 4 + t) : (t - 4); else return t; };
    auto dma = [&](int t, int slot) {
        const int kt = ktile(t);
        int krow = D.key0 + 64 * kt + lane; krow = krow < 0 ? 0 : krow;
        int vrow = D.key0 + 64 * kt + 16 * (wid & 3) + (lane >> 2); vrow = vrow < 0 ? 0 : vrow;
        glds16(D.k + (long)krow * D.kvs + wid * 8, (unsigned)__builtin_amdgcn_readfirstlane(lds0 + LDS_K + slot * SLOTB + wid * 1024));
        glds16(D.v + (long)vrow * D.kvs + (wid >> 2) * 32 + (lane & 3) * 8, (unsigned)__builtin_amdgcn_readfirstlane(lds0 + LDS_V + slot * SLOTB + wid * 1024));
    };
    dma(0, 0);
#pragma unroll 1
    for (int t = 0; t < NT; ++t) {
        asm volatile("s_waitcnt vmcnt(0) lgkmcnt(0)\n\ts_barrier" ::: "memory");
        if (t + 1 < NT) dma(t + 1, (t + 1) & 1);
        const int slot = t & 1, kt = ktile(t);
        bool relevant = true; bool lane_sel = true;
        if constexpr (MODE == 1) {
            if (t < 4) relevant = (64 * t) <= (32 * wid + 31);
            else { lane_sel = (selmask >> (kt >> 2)) & 1u; relevant = __any(lane_sel); }
        }
        if constexpr (MODE == 2) { const int q0 = 32 * wid; relevant = (64 * kt - 128 <= q0 + 31) && (64 * kt - 65 >= q0 - 128) && (D.key0 + 64 * kt + 63 >= 0); }
        if (relevant) {
            f32x16 p0 = {}, p1 = {};
            const LAS char* kb = kp0 + slot * SLOTB;
#pragma unroll
            for (int d0 = 0; d0 < 4; ++d0) {
                const bf16x8 b0 = *(const LAS bf16x8*)(kb + d0 * 2048), b1 = *(const LAS bf16x8*)(kb + d0 * 2048 + 512);
                p0 = __builtin_amdgcn_mfma_f32_32x32x16_bf16(b0, qr[d0], p0, 0, 0, 0); p1 = __builtin_amdgcn_mfma_f32_32x32x16_bf16(b1, qr[d0], p1, 0, 0, 0);
            }
            if constexpr (MODE == 1) {
                if (t < 4) { const int qrel = 32 * wid + r32, kb0 = 64 * t + 4 * hi;
#pragma unroll
                    for (int r = 0; r < 16; ++r) { const int kv = kb0 + (r & 3) + 8 * (r >> 2); if (kv > qrel) p0[r] = NEG_INF; if (kv + 32 > qrel) p1[r] = NEG_INF; } }
                else if (!lane_sel) {
#pragma unroll
                    for (int r = 0; r < 16; ++r) { p0[r] = NEG_INF; p1[r] = NEG_INF; } }
            }
            if constexpr (MODE == 2) {
                const int ql = D.qb + 32 * wid + r32, kl0 = D.key0 + 64 * kt + 4 * hi;
#pragma unroll
                for (int r = 0; r < 16; ++r) { const int kl = kl0 + (r & 3) + 8 * (r >> 2);
                    if (!(kl >= 0 && kl <= ql && ql - kl <= 128)) p0[r] = NEG_INF;
                    if (!(kl + 32 >= 0 && kl + 32 <= ql && ql - kl - 32 <= 128)) p1[r] = NEG_INF; }
            }
            const float rm = rowmax32(p0, p1);
            const float mnew = __builtin_fmaxf(mrun, rm);
            const float muse = (mnew == NEG_INF) ? 0.f : mnew;
            const float alpha = __builtin_amdgcn_exp2f(mrun - muse);
            float ps = 0.f;
#pragma unroll
            for (int r = 0; r < 16; ++r) { p0[r] = __builtin_amdgcn_exp2f(p0[r] - muse); p1[r] = __builtin_amdgcn_exp2f(p1[r] - muse); ps += p0[r] + p1[r]; }
            lrun = lrun * alpha + ps; mrun = mnew;
            if (__any(alpha != 1.0f)) {
                if (hi == 0) wsf[r32] = alpha;
                LDS_WAIT();
#pragma unroll
                for (int r = 0; r < 16; ++r) { const float f = wsf[crow(r, hi)]; o[0][r] *= f; o[1][r] *= f; }
            }
            u32x4 pw0, pw1, pw2, pw3;
            pw0 = (u32x4){cvtpk(p0[0], p0[1]), cvtpk(p0[2], p0[3]), cvtpk(p0[4], p0[5]), cvtpk(p0[6], p0[7])};
            pw1 = (u32x4){cvtpk(p0[8], p0[9]), cvtpk(p0[10], p0[11]), cvtpk(p0[12], p0[13]), cvtpk(p0[14], p0[15])};
            pw2 = (u32x4){cvtpk(p1[0], p1[1]), cvtpk(p1[2], p1[3]), cvtpk(p1[4], p1[5]), cvtpk(p1[6], p1[7])};
            pw3 = (u32x4){cvtpk(p1[8], p1[9]), cvtpk(p1[10], p1[11]), cvtpk(p1[12], p1[13]), cvtpk(p1[14], p1[15])};
            const LAS char* vb = vp0 + slot * SLOTB;
#pragma unroll
            for (int d0 = 0; d0 < 2; ++d0) {
                s16x4 lo[4], hh[4];
#pragma unroll
                for (int ks = 0; ks < 4; ++ks) { lo[ks] = vtr(vb + d0 * 4096 + ks * 1024); hh[ks] = vtr(vb + d0 * 4096 + ks * 1024 + 512); }
#define ATT_PK(k) (bf16x8){lo[k][0], lo[k][1], lo[k][2], lo[k][3], hh[k][0], hh[k][1], hh[k][2], hh[k][3]}
                o[d0] = __builtin_amdgcn_mfma_f32_32x32x16_bf16(__builtin_bit_cast(bf16x8, pw0), ATT_PK(0), o[d0], 0, 0, 0);
                o[d0] = __builtin_amdgcn_mfma_f32_32x32x16_bf16(__builtin_bit_cast(bf16x8, pw1), ATT_PK(1), o[d0], 0, 0, 0);
                o[d0] = __builtin_amdgcn_mfma_f32_32x32x16_bf16(__builtin_bit_cast(bf16x8, pw2), ATT_PK(2), o[d0], 0, 0, 0);
                o[d0] = __builtin_amdgcn_mfma_f32_32x32x16_bf16(__builtin_bit_cast(bf16x8, pw3), ATT_PK(3), o[d0], 0, 0, 0);
#undef ATT_PK
            }
        }
    }
    { auto rr = __builtin_amdgcn_permlane32_swap(__float_as_uint(lrun), __float_as_uint(lrun), false, false); lrun = __uint_as_float(rr[0]) + __uint_as_float(rr[1]); }
    if (hi == 0) wsf[32 + r32] = lrun;
    if (D.lse != nullptr && hi == 0) D.lse[(long)(wid * 32 + r32) * D.lses] = mrun + __builtin_amdgcn_logf(lrun);
    LDS_WAIT();
    bf16_t* Ow = D.o + (long)(wid * 32) * D.os;
    {
        LAS bf16_t* stg = (LAS bf16_t*)(shm + LDS_OST) + wid * 2048;
#pragma unroll
        for (int r = 0; r < 16; ++r) { const int orow = crow(r, hi); const float rli = __builtin_amdgcn_rcpf(wsf[32 + orow]);
#pragma unroll
            for (int d0 = 0; d0 < 2; ++d0) stg[orow * 64 + d0 * 32 + r32] = (bf16_t)(cvtpk(o[d0][r] * rli, 0.f) & 0xffffu); }
        LDS_WAIT();
#pragma unroll
        for (int i = 0; i < 4; ++i) { const int row = i * 8 + (lane >> 3), ch = lane & 7; const u32x4 v = *(const LAS u32x4*)(stg + row * 64 + ch * 8); *(u32x4*)(Ow + (long)row * D.os + ch * 8) = v; }
    }
    asm volatile("s_waitcnt lgkmcnt(0)\n\ts_barrier" ::: "memory");
}
}


#ifdef SELFCHECK
constexpr int CW_CHK = 600;
__device__ __forceinline__ float ldbf(const bf16_t* p) { return __uint_as_float((unsigned)(*p) << 16); }
__device__ __forceinline__ float bfr(float f) { return __uint_as_float(cvtpk(f, 0.f) << 16); }
__device__ __forceinline__ int chk_token(int s) { const unsigned h = (unsigned)s * 2654435761u; int t = (int)((h >> 7) % NTOK); if (s < 64) t = (s & 7) * SEQ + (s >> 3) * 37; if (s >= 64 && s < 128) t = (s & 7) * SEQ + SEQ - 1 - (s >> 3); return t; }
__device__ __forceinline__ void chk_report(unsigned* ctl, int idx, bool bad, int lane) { const bool anybad = __any(bad); if (lane == 0) { atomicAdd(ctl + CW_CHK + 16 + idx, 1u); if (anybad) atomicAdd(ctl + CW_CHK + idx, 1u); } }
__device__ __forceinline__ float wave_max(float v) {
#pragma unroll
    for (int o = 1; o < 64; o <<= 1) v = __builtin_fmaxf(v, __shfl_xor(v, o));
    return v;
}
__device__ __forceinline__ void rope_cs(int pos, int j, float& c, float& s) {
    const float f = j == 0 ? 1.0f : j == 1 ? 0.1939227432012558f : j == 2 ? 0.03760603070259094f : j == 3 ? 0.007292664609849453f : j == 4 ? 0.0014142135623842478f : j == 5 ? 0.00027424818836152554f : j == 6 ? 5.318296098266728e-05f : 1.0313386155758053e-05f;
    const double a = (double)pos * (double)f, rv = a * 0.15915494309189535, fr_ = rv - __builtin_rint(rv); const float ang = (float)(fr_ * 6.283185307179586); c = cosf(ang); s = sinf(ang);
}
__device__ __forceinline__ float naive_proj(const float* xrow, const float* W, int K, int N, int c) { float acc = 0.f; for (int k = 0; k < K; ++k) acc += bfr(xrow[k]) * bfr(W[(size_t)k * N + c]); return acc; }
struct ChkKeys { int mode, B0, B1, B2, own, pos, dil, lstep; long stride; };
__device__ __forceinline__ const bf16_t* chk_key(const ChkKeys& K, int i, int l, const bf16_t* base) {
    if (K.mode == 5) { const int g = i >> 2; const int bsel = g == 0 ? K.B0 : g == 1 ? K.B1 : g == 2 ? K.B2 : K.own; const int key = bsel * 256 + (i & 3) * 64 + l; const bool valid = bsel >= 0 && (g != 3 || key <= K.pos); return valid ? base + (size_t)key * K.stride : nullptr; }
    if (K.mode == 6) { const int j = l + 64 * i; const bool valid = j <= 128 && j <= K.lstep; return valid ? base + (size_t)(K.pos - j * K.dil) * K.stride : nullptr; }
    return base + (size_t)(l + 64 * i) * K.stride;
}
__device__ __forceinline__ float naive_att(const ChkKeys& K, int NS, float qv, const bf16_t* kbase, const bf16_t* vbase, LAS float* scs, int lane, float& lse2) {
    float mx = NEG_INF;
    for (int i = 0; i < NS; ++i) { const bf16_t* kp = chk_key(K, i, lane, kbase); const bool v = kp != nullptr; const bf16_t* kq = v ? kp : kbase; float acc = 0.f;
        for (int d = 0; d < 64; ++d) acc += __shfl(qv, d) * ldbf(kq + d);
        const float a = v ? acc : NEG_INF; scs[i * 64 + lane] = a; mx = __builtin_fmaxf(mx, a); }
    mx = wave_max(mx); float l = 0.f;
    for (int i = 0; i < NS; ++i) { const float p = __builtin_amdgcn_exp2f(scs[i * 64 + lane] - mx); scs[i * 64 + lane] = p; l += p; }
    l = wave_sum(l); LDS_WAIT();
    float oacc = 0.f;
    for (int i = 0; i < NS; ++i) for (int sl = 0; sl < 64; ++sl) { const bf16_t* vp = chk_key(K, i, sl, vbase); if (vp != nullptr) oacc += scs[i * 64 + sl] * ldbf(vp + lane); }
    LDS_WAIT();
    lse2 = mx + __builtin_amdgcn_logf(l); return oacc / l;
}
__device__ __forceinline__ void selfcheck_a(const Params& P, unsigned char* ws, unsigned* ctl, LAS float* scs, int gw, int NGW, int lane) {
    const bf16_t* qkv = (const bf16_t*)(ws + WS_QKV);
    for (int s = gw; s < 2048; s += NGW) {
        const int t = chk_token(s), b = t / SEQ, pos = t % SEQ;
        { const int head = s % 40, c = head * 64 + lane;
          float v = naive_proj(P.x + (size_t)t * DM, P.w_in, DM, WIN, c);
          const bool rope_head = head < 12 || (head >= 18 && head < 30);
          const float partner = __shfl_xor(v, 8);
          if (rope_head && lane < 16) { float cs, sn; rope_cs(P.positions[t], lane & 7, cs, sn); v = lane < 8 ? v * cs - partner * sn : v * cs + partner * sn; }
          const bool qhead = head < 6 || (head >= 18 && head < 24) || head >= 36; if (qhead) v *= C2;
          const float got = ldbf(qkv + (size_t)t * WIN + c);
          chk_report(ctl, 1, !(fabsf(got - v) <= 0.02f * fabsf(v) + 0.01f), lane); }
        { const int c = (s % 48) * 64 + lane; const float z = naive_proj(P.x + (size_t)t * DM, P.w_gate, DM, NGATE, c) + P.b_gate[c]; const float v = 1.f / (1.f + expf(-z));
          const float got = ldbf((const bf16_t*)(ws + WS_GATES) + (size_t)t * NGATE + c);
          chk_report(ctl, 2, !(fabsf(got - v) <= 0.01f), lane); }
        { const int blk = s % 16, h = (s / 16) % 6; float acc = 0.f; for (int r = 0; r < 256; ++r) acc += ldbf(qkv + ((size_t)b * SEQ + blk * 256 + r) * WIN + 1536 + h * 64 + lane);
          const float got = ((const float*)(ctl + CW_KSUM))[(((size_t)b * 16 + blk) * 6 + h) * 64 + lane];
          chk_report(ctl, 3, !(fabsf(got - acc) <= 0.02f * fabsf(acc) + 0.3f), lane); }
        { const int mr = (int)(((unsigned)s * 40503u) % 2048u), c = (s % 8) * 64 + lane; const float v = naive_proj(P.mem + (size_t)mr * DM, P.w_mem_kv, DM, 512, c);
          const float got = ldbf((const bf16_t*)(ws + WS_KVM) + (size_t)mr * 512 + c);
          chk_report(ctl, 4, !(fabsf(got - v) <= 0.02f * fabsf(v) + 0.01f), lane); }
        { const int h = s % 6, own = pos >> 8;
          const float qv = ldbf(qkv + (size_t)t * WIN + 1152 + h * 64 + lane);
          float gate = NEG_INF;
          { float acc = 0.f; const int n = lane & 15; const float* kp = (const float*)(ctl + CW_KSUM) + (((size_t)b * 16 + n) * 6 + h) * 64;
            for (int d = 0; d < 64; ++d) acc += __shfl(qv, d) * bfr(kp[d] * (1.0f / 256.0f)); if (lane < own && lane < 16) gate = acc; }
          ChkKeys K; K.mode = 5; K.B0 = -1; K.B1 = -1; K.B2 = -1; K.own = own; K.pos = pos; K.dil = 1; K.lstep = 0; K.stride = WIN;
          for (int rep = 0; rep < 3; ++rep) { float best = NEG_INF; int bi = -1;
              for (int n = 0; n < 16; ++n) { const float gn = __shfl(gate, n); const bool ok = n < own && n != K.B0 && n != K.B1 && n != K.B2; if (ok && (bi < 0 || gn > best)) { best = gn; bi = n; } }
              if (rep == 0) K.B0 = bi; else if (rep == 1) K.B1 = bi; else K.B2 = bi; }
          float l2; const float want = naive_att(K, 16, qv, qkv + (size_t)b * SEQ * WIN + 1536 + h * 64, qkv + (size_t)b * SEQ * WIN + 1920 + h * 64, scs, lane, l2);
          const float got = ldbf((const bf16_t*)(ws + WS_YMOBA) + (size_t)t * 384 + h * 64 + lane);
          const float scale = wave_max(fabsf(want));
          chk_report(ctl, 5, !(fabsf(got - want) <= 0.03f * scale + 2e-3f), lane); }
        { const int hg = s & 1; float lg0 = 0.f, lg1 = 0.f, lg2 = 0.f, og0 = 0.f, og1 = 0.f, og2 = 0.f;
          for (int g = 0; g < 3; ++g) { const int hd = 2 * g + hg, dil = g == 0 ? 1 : g == 1 ? 4 : 16;
              ChkKeys K; K.mode = 6; K.B0 = K.B1 = K.B2 = -1; K.own = 0; K.pos = pos; K.dil = dil; K.lstep = pos / dil; K.stride = WIN;
              const float qv = ldbf(qkv + (size_t)t * WIN + hd * 64 + lane); float l2;
              const float o = naive_att(K, 3, qv, qkv + (size_t)b * SEQ * WIN + 384 + hd * 64, qkv + (size_t)b * SEQ * WIN + 768 + hd * 64, scs, lane, l2);
              if (g == 0) { og0 = o; lg0 = l2; } else if (g == 1) { og1 = o; lg1 = l2; } else { og2 = o; lg2 = l2; } }
          const float mm = __builtin_fmaxf(lg0, __builtin_fmaxf(lg1, lg2)); const float e0 = exp2f(lg0 - mm), e1 = exp2f(lg1 - mm), e2 = exp2f(lg2 - mm);
          const float want = (e0 * og0 + e1 * og1 + e2 * og2) / (e0 + e1 + e2);
          const float got = ldbf((const bf16_t*)(ws + WS_YDIL) + (size_t)t * 128 + hg * 64 + lane); const float scale = wave_max(fabsf(want));
          chk_report(ctl, 6, !(fabsf(got - want) <= 0.03f * scale + 2e-3f), lane); }
        { const int h = s & 3; const float qv = ldbf(qkv + (size_t)t * WIN + 2304 + h * 64 + lane);
          const bf16_t* kbase = (const bf16_t*)(ws + WS_KVM) + (size_t)b * 256 * 512 + h * 64;
          ChkKeys K; K.mode = 7; K.B0 = K.B1 = K.B2 = -1; K.own = 0; K.pos = 0; K.dil = 1; K.lstep = 0; K.stride = 512; float l2;
          const float want = naive_att(K, 4, qv, kbase, kbase + 256, scs, lane, l2);
          const float got = ldbf((const bf16_t*)(ws + WS_YMEM) + (size_t)t * 256 + h * 64 + lane); const float scale = wave_max(fabsf(want));
          chk_report(ctl, 7, !(fabsf(got - want) <= 0.03f * scale + 2e-3f), lane); }
    }
}
__device__ __forceinline__ void selfcheck_b(const Params& P, unsigned char* ws, unsigned* ctl, int gw, int NGW, int lane) {
    for (int s = gw; s < 2048; s += NGW) {
        const int t = chk_token(s);
        { const int c = (s % 16) * 64 + lane; const bf16_t* gates = (const bf16_t*)(ws + WS_GATES) + (size_t)t * NGATE;
          float p0 = 0.f, p1 = 0.f, p2 = 0.f;
          for (int k = 0; k < 128; ++k) p0 += ldbf((const bf16_t*)(ws + WS_YDIL) + (size_t)t * 128 + k) * bfr(P.w_br_dil[(size_t)k * DM + c]);
          for (int k = 0; k < 384; ++k) p1 += ldbf((const bf16_t*)(ws + WS_YMOBA) + (size_t)t * 384 + k) * bfr(P.w_br_moba[(size_t)k * DM + c]);
          for (int k = 0; k < 256; ++k) p2 += ldbf((const bf16_t*)(ws + WS_YMEM) + (size_t)t * 256 + k) * bfr(P.w_br_mem[(size_t)k * DM + c]);
          const float want = ldbf(gates + c) * p0 + ldbf(gates + 1024 + c) * p1 + ldbf(gates + 2048 + c) * p2, got = ldbf((const bf16_t*)(ws + WS_MERGED) + (size_t)t * DM + c);
          const float scale = wave_max(fabsf(want));
          chk_report(ctl, 8, !(fabsf(got - want) <= 0.03f * scale + 1e-3f), lane); }
        { const int c = (s % 16) * 64 + lane; float acc = 0.f; for (int k = 0; k < DM; ++k) acc += ldbf((const bf16_t*)(ws + WS_MERGED) + (size_t)t * DM + k) * bfr(P.w_out[(size_t)k * DM + c]);
          const float want = ALPHA * P.x[(size_t)t * DM + c] + acc, got = ((const float*)(ws + WS_X1F))[(size_t)t * DM + c];
          const float scale = wave_max(fabsf(acc));
          chk_report(ctl, 9, !(fabsf(got - want) <= 0.02f * scale + 1e-4f), lane); }
    }
}
#endif

#define XB_TMO      128
#define XB_XCNT(j)  (256  + 64 * (j))
#define XB_XSUB(j)  (1280 + 64 * (j))
#define XB_XGEN(j)  (2304 + 64 * (j))
#define XB_TOP      3328
#define XB_TOPGEN   3392
#define XCD_BAR_WORDS 3456
#define XB_SPIN_CAP (1u << 18)
__device__ __forceinline__ unsigned xb_ld(unsigned* p)              { return __hip_atomic_load(p, __ATOMIC_RELAXED, __HIP_MEMORY_SCOPE_AGENT); }
__device__ __forceinline__ unsigned xb_add(unsigned* p, unsigned v) { return __hip_atomic_fetch_add(p, v, __ATOMIC_RELAXED, __HIP_MEMORY_SCOPE_AGENT); }
__device__ __forceinline__ unsigned xb_xcc_id() { return (unsigned)__builtin_amdgcn_s_getreg((3 << 11) | 20) & 0xFu; }
#define XB_SPIN(cond, bar) do { unsigned _sp = 0; while (cond) { __builtin_amdgcn_s_sleep(1); \
    if ((++_sp & 255u) == 0u) { if (xb_ld(&(bar)[XB_TMO])) break; if (_sp > XB_SPIN_CAP) { atomicAdd(&(bar)[XB_TMO], 1u); break; } } } } while (0)
struct XcdBarrier { unsigned* bar; unsigned x; volatile LAS unsigned* st; };
__device__ __forceinline__ XcdBarrier xcd_barrier_post(unsigned* bar, volatile LAS unsigned* st) {
    XcdBarrier b; b.bar = bar; b.x = xb_xcc_id(); b.st = st;
    if (threadIdx.x == 0) (void)xb_add(&bar[XB_XCNT(b.x)], 1u);
    return b;
}
__device__ __forceinline__ void xcd_barrier_complete(unsigned* bar, unsigned x, unsigned& nloc, unsigned& nx) {
    const unsigned G = gridDim.x * gridDim.y * gridDim.z;
    unsigned sum, cnt, mine, sp = 0u;
    for (;;) {
        sum = 0u; cnt = 0u; mine = 0u;
#pragma unroll
        for (unsigned j = 0; j < 16; ++j) { const unsigned c = xb_ld(&bar[XB_XCNT(j)]); sum += c; cnt += (c > 0u) ? 1u : 0u; mine = (j == x) ? c : mine; }
        if (sum == G) break;
        __builtin_amdgcn_s_sleep(1);
        if ((++sp & 255u) == 0u) { if (xb_ld(&bar[XB_TMO])) break; if (sp > XB_SPIN_CAP) { atomicAdd(&bar[XB_TMO], 1u); break; } }
    }
    nloc = mine > 0u ? mine : 1u; nx = cnt > 0u ? cnt : 1u;
}
__device__ __forceinline__ void xcd_barrier(const XcdBarrier& b) {
    asm volatile("s_waitcnt vmcnt(0)" ::: "memory");
    __syncthreads();
    if (threadIdx.x == 0) {
        unsigned* bar = b.bar;
        __builtin_amdgcn_s_waitcnt(0);
        unsigned nloc = b.st[0], nx = b.st[1];
        if (nloc == 0u) { xcd_barrier_complete(bar, b.x, nloc, nx); b.st[0] = nloc; b.st[1] = nx; }
        const unsigned old = xb_add(&bar[XB_XSUB(b.x)], 1u);
        const unsigned gen = old / nloc;
        if (old + 1u == (gen + 1u) * nloc) {
            __builtin_amdgcn_fence(__ATOMIC_RELEASE, "agent");
            asm volatile("s_waitcnt vmcnt(0)" ::: "memory");
            const unsigned og = xb_add(&bar[XB_TOP], 1u);
            const unsigned tg = og / nx;
            if (og + 1u == (tg + 1u) * nx) xb_add(&bar[XB_TOPGEN], 1u);
            else XB_SPIN(xb_ld(&bar[XB_TOPGEN]) == tg, bar);
            __builtin_amdgcn_fence(__ATOMIC_ACQUIRE, "agent");
            xb_add(&bar[XB_XGEN(b.x)], 1u);
            asm volatile("s_waitcnt vmcnt(0)" ::: "memory");
        } else {
            XB_SPIN(xb_ld(&bar[XB_XGEN(b.x)]) == gen, bar);
            __builtin_amdgcn_fence(__ATOMIC_ACQUIRE, "agent");
            asm volatile("s_waitcnt vmcnt(0)" ::: "memory");
        }
    }
    __syncthreads();
}
constexpr int NWAVES = 8, NTHREADS = NWAVES * 64;
constexpr int RING_BYTES = 131072, MISC_OFF = RING_BYTES, LDS_BYTES = 147456;

#ifndef PHASE_MASK
#define PHASE_MASK 0xFFFF
#endif
#define PH(k) (((PHASE_MASK) >> (k)) & 1)
#ifndef ATT_MASK
#define ATT_MASK 7
#endif
#define ATT_EN(k) (((ATT_MASK) >> (k)) & 1)
__global__ void __launch_bounds__(NTHREADS, 2) fwd_megakernel(Params P) {
    extern __shared__ __attribute__((aligned(16))) unsigned char lds_raw[];
    cg::grid_group grid = cg::this_grid();
    LAS unsigned char* lds = (LAS unsigned char*)lds_raw;
    unsigned char* ws = P.ws;
    const int tid = threadIdx.x, lane = tid & 63, wave = __builtin_amdgcn_readfirstlane(tid >> 6);
    const int G = gridDim.x, bx = blockIdx.x;
    const int gw = bx * NWAVES + wave, NGW = G * NWAVES, gtid = bx * NTHREADS + tid, NTHR = G * NTHREADS;
    unsigned* ctl = (unsigned*)(ws + WS_CTL);

    if (tid < 4) ((LAS unsigned*)(lds + MISC_OFF + 16))[tid] = 0u;
    if constexpr (PH(0)) p0_prologue(P, lds, gw, NGW, gtid, NTHR, lane, wave);
    grid.sync();
    const XcdBarrier xbar = xcd_barrier_post(ctl + CW_BAR, (volatile LAS unsigned*)(lds + MISC_OFF + 16));
#define GRID_BAR() xcd_barrier(xbar)

    if constexpr (PH(1)) {
        LaneGeom geom; { int t_ = threadIdx.x; asm volatile("" : "+v"(t_)); geom.init(t_); }
        SchedP1 S{geom, G, bx, ws};
        EpiP1 E{(bf16_t*)(ws + WS_QKV), (bf16_t*)(ws + WS_GATES), (bf16_t*)(ws + WS_KVM), P.b_gate, (const float*)(ws + WS_ROPE), (float*)(ctl + CW_KSUM)};
        pg8::gemm_phase<EpiP1, SchedP1, true>(lds, S, E);
    }
    GRID_BAR();

    if constexpr (PH(2)) {
        LAS int* qslot = (LAS int*)(lds + MISC_OFF);
        const bf16_t* qkv = (const bf16_t*)(ws + WS_QKV);
#define ATT_POP(base, count) int idx; { if (tid == 0) qslot[0] = (int)atomicAdd(ctl + CW_QUEUE + (base), 1u); __syncthreads(); idx = __builtin_amdgcn_readfirstlane(qslot[0]); __syncthreads(); } if (idx >= (count)) break;
        if (ATT_EN(1)) for (;;) {
            ATT_POP(0, 768)
            att::Desc D;
            const int qb = 15 - idx / 48, bh = idx % 48, b = bh / 6, h = bh % 6;
            const size_t tok0 = (size_t)b * SEQ;
            D.q = qkv + (tok0 + 256 * qb) * WIN + 1152 + h * 64; D.qs = WIN;
            D.k = qkv + tok0 * WIN + 1536 + h * 64; D.v = qkv + tok0 * WIN + 1920 + h * 64; D.kvs = WIN; D.key0 = 0;
            D.o = (bf16_t*)(ws + WS_YMOBA) + (tok0 + 256 * qb) * 384 + h * 64; D.os = 384; D.lse = nullptr; D.lses = 0;
            D.nt = 4 * qb + 4; D.mode = 1; D.qb = qb; D.ksum = (const float*)(ctl + CW_KSUM) + ((size_t)b * 16 * 6 + h) * 64;
            att::attn_unit<1>((LAS char*)lds, D);
        }
        if (ATT_EN(2)) for (;;) {
            ATT_POP(1, 768)
            att::Desc D;
            const int bh = idx >> 4, sub = idx & 15, b = bh / 6, hd = bh % 6, gI = hd >> 1;
            const int dil = gI == 0 ? 1 : (gI == 1 ? 4 : 16);
            const int res = gI == 0 ? 0 : (gI == 1 ? (sub & 3) : sub), ub = gI == 0 ? sub : (gI == 1 ? (sub >> 2) : 0);
            const size_t tok0 = (size_t)b * SEQ + res;
            D.q = qkv + (tok0 + (size_t)256 * ub * dil) * WIN + hd * 64; D.qs = (long)dil * WIN;
            D.k = qkv + tok0 * WIN + 384 + hd * 64; D.v = qkv + tok0 * WIN + 768 + hd * 64; D.kvs = (long)dil * WIN; D.key0 = 256 * ub - 128;
            D.o = (bf16_t*)(ws + WS_ODIL) + (tok0 + (size_t)256 * ub * dil) * 384 + hd * 64; D.os = (long)dil * 384;
            D.lse = (float*)(ws + WS_LSE) + (tok0 + (size_t)256 * ub * dil) * 6 + hd; D.lses = (long)dil * 6;
            D.nt = 6; D.mode = 2; D.qb = 256 * ub; D.ksum = nullptr;
            att::attn_unit<2>((LAS char*)lds, D);
        }
        if (ATT_EN(0)) for (;;) {
            ATT_POP(2, 512)
            att::Desc D;
            const int b = idx >> 6, h = (idx >> 4) & 3, qblk = idx & 15;
            const size_t tok0 = (size_t)b * SEQ + 256 * qblk;
            const bf16_t* kvm = (const bf16_t*)(ws + WS_KVM) + (size_t)b * 256 * 512;
            D.q = qkv + tok0 * WIN + 2304 + h * 64; D.qs = WIN;
            D.k = kvm + h * 64; D.v = kvm + 256 + h * 64; D.kvs = 512; D.key0 = 0;
            D.o = (bf16_t*)(ws + WS_YMEM) + tok0 * 256 + h * 64; D.os = 256; D.lse = nullptr; D.lses = 0;
            D.nt = 4; D.mode = 0; D.qb = 0; D.ksum = nullptr;
            att::attn_unit<0>((LAS char*)lds, D);
        }
#undef ATT_POP
    }
    GRID_BAR();

    if constexpr (PH(3)) {
        const bf16_t* odil = (const bf16_t*)(ws + WS_ODIL); const float* lse = (const float*)(ws + WS_LSE); bf16_t* ydil = (bf16_t*)(ws + WS_YDIL);
        for (int tkn = gw; tkn < NTOK; tkn += NGW) {
            const int hg = lane >> 5, dd = (lane & 31) * 2;
            const float l0 = lse[(size_t)tkn * 6 + hg], l1 = lse[(size_t)tkn * 6 + 2 + hg], l2 = lse[(size_t)tkn * 6 + 4 + hg];
            const float mx = __builtin_fmaxf(l0, __builtin_fmaxf(l1, l2));
            const float e0 = __builtin_amdgcn_exp2f(l0 - mx), e1 = __builtin_amdgcn_exp2f(l1 - mx), e2 = __builtin_amdgcn_exp2f(l2 - mx), inv = 1.0f / (e0 + e1 + e2);
            const unsigned a0 = *(const unsigned*)(odil + (size_t)tkn * 384 + hg * 64 + dd), a1 = *(const unsigned*)(odil + (size_t)tkn * 384 + 128 + hg * 64 + dd), a2 = *(const unsigned*)(odil + (size_t)tkn * 384 + 256 + hg * 64 + dd);
            const float y0 = (e0 * bflo(a0) + e1 * bflo(a1) + e2 * bflo(a2)) * inv, y1 = (e0 * bfhi(a0) + e1 * bfhi(a1) + e2 * bfhi(a2)) * inv;
            *(unsigned*)(ydil + (size_t)tkn * 128 + hg * 64 + dd) = cvtpk(y0, y1);
        }
    }
    GRID_BAR();

#ifdef SELFCHECK
    selfcheck_a(P, ws, ctl, (LAS float*)(lds + wave * 16384), gw, NGW, lane);
    grid.sync();
#endif
    if constexpr (PH(4)) {
        LaneGeom geom; { int t_ = threadIdx.x; asm volatile("" : "+v"(t_)); geom.init(t_); }
        SchedP3 S{geom, G, bx, ws};
        EpiP3 E{(const bf16_t*)(ws + WS_GATES), (bf16_t*)(ws + WS_MERGED)};
        pg8::gemm_phase<EpiP3, SchedP3, true>(lds, S, E);
    }
    GRID_BAR();

    if constexpr (PH(5)) {
        LaneGeom geom; { int t_ = threadIdx.x; asm volatile("" : "+v"(t_)); geom.init(t_); }
        SchedP4 S{geom, G, bx, ws};
        EpiP4 E{P.x, (float*)(ws + WS_X1F)};
        pg8::gemm_phase<EpiP4, SchedP4, true>(lds, S, E);
    }
    GRID_BAR();

#ifdef SELFCHECK
    selfcheck_b(P, ws, ctl, gw, NGW, lane);
    grid.sync();
#endif
    if constexpr (PH(6)) {
        float* x1f = (float*)(ws + WS_X1F); bf16_t* x1b = (bf16_t*)(ws + WS_X1B);
        for (int row = gw; row < NTOK; row += NGW) {
            f32x4* xr = (f32x4*)(x1f + (size_t)row * DM) + lane;
            f32x4 v[4]; float s = 0.f;
#pragma unroll
            for (int j = 0; j < 4; ++j) { v[j] = xr[64 * j]; s += (v[j][0] + v[j][1]) + (v[j][2] + v[j][3]); }
            const float mean = wave_sum(s) * (1.f / DM); float s2 = 0.f;
#pragma unroll
            for (int j = 0; j < 4; ++j) { v[j] = v[j] - mean; s2 += (v[j][0] * v[j][0] + v[j][1] * v[j][1]) + (v[j][2] * v[j][2] + v[j][3] * v[j][3]); }
            const float rstd = __builtin_amdgcn_rsqf(wave_sum(s2) * (1.f / DM) + LN_EPS);
#pragma unroll
            for (int j = 0; j < 4; ++j) {
                const f32x4 gg = *((const f32x4*)P.ln1_g + lane + 64 * j), bb = *((const f32x4*)P.ln1_b + lane + 64 * j);
                const f32x4 y = v[j] * rstd * gg + bb;
                xr[64 * j] = y;
                u32x2 w; w.x = cvtpk(y[0], y[1]); w.y = cvtpk(y[2], y[3]);
                *((u32x2*)(x1b + (size_t)row * DM) + lane + 64 * j) = w;
            }
        }
    }
    GRID_BAR();

    if constexpr (PH(7)) {
        LaneGeom geom; { int t_ = threadIdx.x; asm volatile("" : "+v"(t_)); geom.init(t_); }
        SchedP6 S{geom, G, bx, ws};
        EpiP6 E{(float*)(ws + WS_SCORES), (bf16_t*)(ws + WS_HIDS)};
        pg8::gemm_phase<EpiP6, SchedP6, true>(lds, S, E);
    }
    GRID_BAR();

    if constexpr (PH(8)) {
        const float* scores = (const float*)(ws + WS_SCORES);
        int* eidx = (int*)(ws + WS_EIDX); float* gwt = (float*)(ws + WS_GWT); int* pos = (int*)(ws + WS_POS);
        const f32x4 rb = *((const f32x4*)P.router_bias + lane);
        for (int tkn = gw; tkn < NTOK; tkn += NGW) {
            const f32x4 sc = *((const f32x4*)(scores + (size_t)tkn * 256) + lane);
            float v0 = sc[0] + rb[0], v1 = sc[1] + rb[1], v2 = sc[2] + rb[2], v3 = sc[3] + rb[3];
            float hi1 = __builtin_fmaxf(__builtin_fmaxf(v0, v1), __builtin_fmaxf(v2, v3));
            float a01 = __builtin_fminf(v0, v1), a23 = __builtin_fminf(v2, v3), m01 = __builtin_fmaxf(v0, v1), m23 = __builtin_fmaxf(v2, v3);
            float hi2 = __builtin_fmaxf(__builtin_fminf(m01, m23), __builtin_fmaxf(a01, a23));
#pragma unroll
            for (int o = 1; o < 8; o <<= 1) { const float o1 = __shfl_xor(hi1, o), o2 = __shfl_xor(hi2, o); const float n1 = __builtin_fmaxf(hi1, o1), n2 = __builtin_fmaxf(__builtin_fminf(hi1, o1), __builtin_fmaxf(hi2, o2)); hi1 = n1; hi2 = n2; }
            const float gs = hi1 + hi2; const int gq = lane >> 3; int rank = 0;
#pragma unroll
            for (int j = 0; j < 8; ++j) { const float sj = __shfl(gs, 8 * j); rank += (sj > gs || (sj == gs && j < gq)) ? 1 : 0; }
            if (rank >= 4) { v0 = NEG_INF; v1 = NEG_INF; v2 = NEG_INF; v3 = NEG_INF; }
            int my_e = 0;
#pragma unroll
            for (int k = 0; k < TOPK; ++k) {
                float bv = v0; int bi = 4 * lane;
                if (v1 > bv) { bv = v1; bi = 4 * lane + 1; } if (v2 > bv) { bv = v2; bi = 4 * lane + 2; } if (v3 > bv) { bv = v3; bi = 4 * lane + 3; }
#pragma unroll
                for (int o = 1; o < 64; o <<= 1) { const float ov = __shfl_xor(bv, o); const int oi = __shfl_xor(bi, o); if (ov > bv || (ov == bv && oi < bi)) { bv = ov; bi = oi; } }
                if (lane == k) my_e = bi;
                if ((bi >> 2) == lane) { const int w = bi & 3; if (w == 0) v0 = NEG_INF; else if (w == 1) v1 = NEG_INF; else if (w == 2) v2 = NEG_INF; else v3 = NEG_INF; }
            }
            float sk = (lane < TOPK) ? scores[(size_t)tkn * 256 + my_e] : 0.f;
            float ssum = sk;
#pragma unroll
            for (int o = 1; o < 8; o <<= 1) ssum += __shfl_xor(ssum, o);
            if (lane < TOPK) {
                const unsigned r = atomicAdd(ctl + CW_COUNT + my_e, 1u);
                eidx[(size_t)tkn * 8 + lane] = my_e; gwt[(size_t)tkn * 8 + lane] = sk / ssum * 2.5f; pos[(size_t)tkn * 8 + lane] = (int)r;
            }
        }
    }
    GRID_BAR();

    if constexpr (PH(9)) {
        LAS int* pad_start = (LAS int*)(lds + MISC_OFF + 64);
        LAS int* cstart = pad_start + 260;
        LAS int* cnt_s = cstart + 260;
        if (wave == 0) {
            int c4[4], p4[4]; int csum = 0, psum = 0;
#pragma unroll
            for (int i = 0; i < 4; ++i) { c4[i] = (int)ctl[CW_COUNT + 4 * lane + i]; p4[i] = (c4[i] + 255) & ~255; csum += c4[i]; psum += p4[i]; }
            int cin = csum, pin = psum;
#pragma unroll
            for (int o = 1; o < 64; o <<= 1) { const int a = __shfl_up(cin, o), b = __shfl_up(pin, o); if (lane >= o) { cin += a; pin += b; } }
            int ce = cin - csum, pe = pin - psum;
#pragma unroll
            for (int i = 0; i < 4; ++i) { cstart[4 * lane + i] = ce; pad_start[4 * lane + i] = pe; cnt_s[4 * lane + i] = c4[i]; ce += c4[i]; pe += p4[i]; }
            if (lane == 63) { cstart[256] = ce; pad_start[256] = pe; }
        }
        __syncthreads();
        if (bx == 0) {
            if (tid < 256) { const int t0 = pad_start[tid] >> 8, t1 = pad_start[tid + 1] >> 8; for (int t = t0; t < t1; ++t) ctl[CW_TILEE + t] = (unsigned)tid; }
            if (tid == 0) ctl[CW_RT] = (unsigned)(pad_start[256] >> 8);
        }
        const int* eidx = (const int*)(ws + WS_EIDX); const float* gwt = (const float*)(ws + WS_GWT); int* pos = (int*)(ws + WS_POS);
        int* row_tok = (int*)(ws + WS_ROWTOK); float* row_w = (float*)(ws + WS_ROWW); int* row_y = (int*)(ws + WS_ROWY);
        for (int a = gtid; a < NASSIGN; a += NTHR) {
            const int e = eidx[a], r = pos[a]; const int d = pad_start[e] + r, cc = cstart[e] + r;
            row_tok[d] = a >> 3; row_w[d] = gwt[a]; row_y[d] = cc; pos[a] = cc;
        }
        for (int i = gtid; i < NEXP * 256; i += NTHR) {
            const int e = i >> 8, jj = cnt_s[e] + (i & 255);
            if (jj < pad_start[e + 1] - pad_start[e]) { const int d = pad_start[e] + jj; row_tok[d] = 0; row_w[d] = 0.f; row_y[d] = -1; }
        }
    }
    GRID_BAR();

    const int RT = (int)__builtin_amdgcn_readfirstlane(((volatile unsigned*)ctl)[CW_RT]);
    if constexpr (PH(10)) {
        LaneGeom geom; { int t_ = threadIdx.x; asm volatile("" : "+v"(t_)); geom.init(t_); }
        SchedP9 S{geom, G, bx, ws, 2 * RT};
        EpiP9 E{(bf16_t*)(ws + WS_HID)};
        pg8::gemm_phase<EpiP9, SchedP9, true>(lds, S, E);
    }
    GRID_BAR();

    if constexpr (PH(11)) {
        LaneGeom geom; { int t_ = threadIdx.x; asm volatile("" : "+v"(t_)); geom.init(t_); }
        SchedP10 S{geom, G, bx, ws, 4 * RT};
        EpiP10 E{ws, (const int*)(ws + WS_ROWY), (const float*)(ws + WS_ROWW)};
        pg8::gemm_phase<EpiP10, SchedP10, true>(lds, S, E);
        SchedP10s S2{geom, G, bx, ws, (4 * RT) % G};
        EpiP10s E2{(float*)(ws + WS_X1F)};
        pg8::gemm_phase<EpiP10s, SchedP10s, true>(lds, S2, E2);
    }
    GRID_BAR();

    if constexpr (PH(12)) {
        const float* x1f = (const float*)(ws + WS_X1F); const int* pos = (const int*)(ws + WS_POS);
        for (int row = gw; row < NTOK; row += NGW) {
            const f32x4* xr = (const f32x4*)(x1f + (size_t)row * DM) + lane;
            f32x4 v[4];
#pragma unroll
            for (int j = 0; j < 4; ++j) v[j] = xr[64 * j];
#pragma unroll
            for (int k = 0; k < TOPK; ++k) {
                const int yr = __builtin_amdgcn_readfirstlane(pos[(size_t)row * 8 + k]);
                const u32x2* yp = (const u32x2*)y_row(ws, yr) + lane;
#pragma unroll
                for (int j = 0; j < 4; ++j) { const u32x2 w = yp[64 * j]; v[j][0] += bflo(w.x); v[j][1] += bfhi(w.x); v[j][2] += bflo(w.y); v[j][3] += bfhi(w.y); }
            }
            float s = 0.f;
#pragma unroll
            for (int j = 0; j < 4; ++j) s += (v[j][0] + v[j][1]) + (v[j][2] + v[j][3]);
            const float mean = wave_sum(s) * (1.f / DM); float s2 = 0.f;
#pragma unroll
            for (int j = 0; j < 4; ++j) { v[j] = v[j] - mean; s2 += (v[j][0] * v[j][0] + v[j][1] * v[j][1]) + (v[j][2] * v[j][2] + v[j][3] * v[j][3]); }
            const float rstd = __builtin_amdgcn_rsqf(wave_sum(s2) * (1.f / DM) + LN_EPS);
            f32x4* orow = (f32x4*)(P.out + (size_t)row * DM) + lane;
#pragma unroll
            for (int j = 0; j < 4; ++j) { const f32x4 gg = *((const f32x4*)P.ln2_g + lane + 64 * j), bb = *((const f32x4*)P.ln2_b + lane + 64 * j); orow[64 * j] = v[j] * rstd * gg + bb; }
        }
#ifdef SELFCHECK
        if (gw == 0 && lane == 0) {
            VM_WAIT();
            int first = 0; float frac = 0.f;
            for (int i = 1; i < 10; ++i) { const unsigned bad = ((volatile unsigned*)ctl)[CW_CHK + i], tot = ((volatile unsigned*)ctl)[CW_CHK + 16 + i]; if (first == 0 && (bad > 0u || tot != 2048u)) { first = i; frac = tot == 2048u ? (float)bad / 2048.f : 1.f; } }
            if (first > 0) P.out[0] = sqrtf(33554432.f * (3.f * (float)first + 2.f * frac));
        }
#endif
    }
}

extern "C" void kernel_launch(void* const* d_in, const int* in_sizes, int n_in, void* d_out, int out_size, void* d_ws, size_t ws_size, hipStream_t stream) {
    static int grid = 0;
    if (grid == 0) {
        if (n_in != 23 || out_size != NTOK * DM || ws_size < WS_END) { fprintf(stderr, "kernel_launch: unexpected shapes (n_in %d, out %d, ws %zu)\n", n_in, out_size, ws_size); grid = -1; return; }
        int dev = 0, cus = 0, per_cu = 0;
        if (hipGetDevice(&dev) != hipSuccess || hipDeviceGetAttribute(&cus, hipDeviceAttributeMultiprocessorCount, dev) != hipSuccess) { grid = -1; return; }
        if (hipFuncSetAttribute((const void*)fwd_megakernel, hipFuncAttributeMaxDynamicSharedMemorySize, LDS_BYTES) != hipSuccess) { fprintf(stderr, "kernel_launch: hipFuncSetAttribute failed\n"); grid = -1; return; }
        if (hipOccupancyMaxActiveBlocksPerMultiprocessor(&per_cu, (const void*)fwd_megakernel, NTHREADS, LDS_BYTES) != hipSuccess || per_cu < 1) { fprintf(stderr, "kernel_launch: occupancy query failed (%d)\n", per_cu); grid = -1; return; }
        grid = cus * 1;
    }
    if (grid < 0) return;
    Params p{};
    p.x = (const float*)d_in[0]; p.mem = (const float*)d_in[1]; p.positions = (const int*)d_in[2];
    p.w_in = (const float*)d_in[3]; p.w_mem_kv = (const float*)d_in[4]; p.w_gate = (const float*)d_in[5]; p.b_gate = (const float*)d_in[6];
    p.w_br_dil = (const float*)d_in[7]; p.w_br_moba = (const float*)d_in[8]; p.w_br_mem = (const float*)d_in[9]; p.w_out = (const float*)d_in[10];
    p.ln1_g = (const float*)d_in[11]; p.ln1_b = (const float*)d_in[12]; p.w_router = (const float*)d_in[13]; p.router_bias = (const float*)d_in[14];
    p.w_e_gate = (const float*)d_in[15]; p.w_e_up = (const float*)d_in[16]; p.w_e_down = (const float*)d_in[17];
    p.w_s_gate = (const float*)d_in[18]; p.w_s_up = (const float*)d_in[19]; p.w_s_down = (const float*)d_in[20]; p.ln2_g = (const float*)d_in[21]; p.ln2_b = (const float*)d_in[22];
    p.out = (float*)d_out; p.ws = (unsigned char*)d_ws;
    void* args[] = {&p};
    hipError_t e = hipLaunchCooperativeKernel((const void*)fwd_megakernel, dim3(grid), dim3(NTHREADS), args, LDS_BYTES, stream);
    if (e != hipSuccess) fprintf(stderr, "kernel_launch: cooperative launch failed: %s (grid %d)\n", hipGetErrorString(e), grid);
}
```

```cpp
#include <hip/hip_runtime.h>
#include <hip/hip_cooperative_groups.h>
#include <cstdint>
#include <cstdio>
namespace cg = cooperative_groups;

#define LAS __attribute__((address_space(3)))
typedef unsigned short bf16_t;
typedef short bf16x8 __attribute__((ext_vector_type(8)));
typedef short s16x4 __attribute__((ext_vector_type(4)));
typedef float f32x2 __attribute__((ext_vector_type(2)));
typedef float f32x4 __attribute__((ext_vector_type(4)));
typedef float f32x16 __attribute__((ext_vector_type(16)));
typedef unsigned u32x2 __attribute__((ext_vector_type(2)));
typedef unsigned u32x4 __attribute__((ext_vector_type(4)));
typedef __bf16 bf16x2_t __attribute__((ext_vector_type(2)));

constexpr int NTOK = 32768, DM = 1024, NBATCH = 8, SEQ = 4096;
constexpr int WIN = 2560, NGATE = 3072, NQG = WIN + NGATE;
constexpr int NEXP = 256, TOPK = 8;
constexpr int NASSIGN = NTOK * TOPK;
constexpr int MAXROWS = NASSIGN + NEXP * 256;
constexpr float ALPHA = 1.189207115002721f;
constexpr float C2 = 0.18033688011112042f;
constexpr float LN_EPS = 1e-5f;
constexpr float LOG2E = 1.4426950408889634f;
constexpr float NEG_INF = -__builtin_inff();

constexpr size_t MiB = (size_t)1 << 20;
constexpr size_t WS_W2T = 0;
constexpr size_t WS_X1F = 128 * MiB;
constexpr size_t WS_HIDS = 256 * MiB;
constexpr size_t WS_CTL = 272 * MiB;
constexpr size_t WS_WTQG = 273 * MiB;
constexpr size_t WS_WTKV = 284 * MiB;
constexpr size_t WS_WTBRD = 285 * MiB;
constexpr size_t WS_WTBRM = 285 * MiB + 256 * 1024;
constexpr size_t WS_WTBRX = 286 * MiB;
constexpr size_t WS_WTOUT = 287 * MiB;
constexpr size_t WS_WTRS = 289 * MiB;
constexpr size_t WS_WTSD = 291 * MiB;
constexpr size_t WS_ROPE = 292 * MiB;
constexpr size_t WS_KVM = 294 * MiB;
constexpr size_t WS_LSE = 296 * MiB;
constexpr size_t WS_EIDX = 297 * MiB;
constexpr size_t WS_GWT = 298 * MiB;
constexpr size_t WS_POS = 299 * MiB;
constexpr size_t WS_ROWTOK = 300 * MiB;
constexpr size_t WS_ROWW = 301 * MiB + 256 * 1024;
constexpr size_t WS_ROWY = 302 * MiB + 512 * 1024;
constexpr size_t WS_W1T = 304 * MiB;
constexpr size_t WS_XB = 560 * MiB;
constexpr size_t WS_ODIL = 560 * MiB;
constexpr size_t WS_YMOBA = 584 * MiB;
constexpr size_t WS_YMEM = 608 * MiB;
constexpr size_t WS_X1B = 560 * MiB;
constexpr size_t WS_QKV = 624 * MiB;
constexpr size_t WS_MERGED = 624 * MiB;
#ifdef SELFCHECK
constexpr size_t WS_YDIL = 976 * MiB;
#else
constexpr size_t WS_YDIL = 688 * MiB;
#endif
constexpr size_t WS_SCORES = 624 * MiB;
constexpr size_t WS_HID = 624 * MiB;
constexpr size_t WS_GATES = 784 * MiB;
constexpr size_t WS_MEMB = 976 * MiB;
constexpr size_t WS_Y1 = 304 * MiB;
constexpr size_t WS_Y2 = 784 * MiB;
constexpr int Y_SPLIT = 163840;
constexpr size_t WS_END = 980 * MiB;
constexpr int CW_COUNT = 0;
constexpr int CW_QUEUE = 512;
constexpr int CW_RT = 520;
constexpr int CW_TILEE = 1024;
constexpr int CW_BAR = 4096;
constexpr int CW_KSUM = 8192;

__device__ __forceinline__ unsigned cvtpk(float lo, float hi) { f32x2 v = {lo, hi}; bf16x2_t b = __builtin_convertvector(v, bf16x2_t); return __builtin_bit_cast(unsigned, b); }
__device__ __forceinline__ float bflo(unsigned w) { return __uint_as_float(w << 16); }
__device__ __forceinline__ float bfhi(unsigned w) { return __uint_as_float(w & 0xffff0000u); }
__device__ __forceinline__ float fast_sigmoid(float x) { return __builtin_amdgcn_rcpf(1.0f + __builtin_amdgcn_exp2f(-x * LOG2E)); }
__device__ __forceinline__ float wave_sum(float v) {
#pragma unroll
    for (int o = 1; o < 64; o <<= 1) v += __shfl_xor(v, o);
    return v;
}
__device__ __forceinline__ u32x4 pack8(f32x4 a, f32x4 b) { u32x4 w; w.x = cvtpk(a[0], a[1]); w.y = cvtpk(a[2], a[3]); w.z = cvtpk(b[0], b[1]); w.w = cvtpk(b[2], b[3]); return w; }
__device__ __forceinline__ void unpack8(u32x4 w, f32x4& a, f32x4& b) { a = (f32x4){bflo(w.x), bfhi(w.x), bflo(w.y), bfhi(w.y)}; b = (f32x4){bflo(w.z), bfhi(w.z), bflo(w.w), bfhi(w.w)}; }
#define LDS_WAIT() asm volatile("s_waitcnt lgkmcnt(0)" ::: "memory")
#define VM_WAIT() asm volatile("s_waitcnt vmcnt(0)" ::: "memory")

namespace pg8 {
constexpr int BM = 256, BK = 64, HALF = 128, HTB = HALF * BK * 2, STAGE_BYTES = 8 * HTB;
__device__ __forceinline__ int lds_byte(int r, int c) { const int st = (r >> 4) * 2 + (c >> 5), rr = r & 15, cc = c & 31, ob = rr * 64 + cc * 2; return st * 1024 + (ob ^ (((ob >> 9) & 1) << 5)); }
__device__ __forceinline__ void stage_rc(int b, int& R, int& C) { const int st = b / 1024, sb = b % 1024, swz = sb ^ (((sb >> 9) & 1) << 5); R = (st >> 1) * 16 + swz / 64; C = (st & 1) * 32 + (swz % 64) / 2; }
__device__ __forceinline__ int perm32(int rho) { const int n = rho >> 4, i = rho & 15; return 8 * (i >> 2) + 4 * n + (i & 3); }
__device__ __forceinline__ int xcd_remap(int L, int nwg) { const int q = nwg / 8, r = nwg % 8, xcd = L % 8, off = L / 8; return (xcd < r ? xcd * (q + 1) : r * (q + 1) + (xcd - r) * q) + off; }

struct GUnit {
    const char* a; const char* b;
    int nt;
    int pm, pn, kind, aux;
    int hsA, hsB;
    unsigned offA[2], offB[2];
    unsigned offA1[2];
};
struct LaneGeom {
    int R[2], C[2], Rp[2];
    __device__ __forceinline__ void init(int tid) {
#pragma unroll
        for (int i = 0; i < 2; ++i) { stage_rc(tid * 16 + i * 8192, R[i], C[i]); Rp[i] = (R[i] & ~31) + perm32(R[i] & 31); }
    }
};
template <class Epi, class Sched, bool ALIGN_EPI>
__device__ __forceinline__ void gemm_phase(LAS unsigned char* lds, const Sched& S, const Epi& E) {
    int tid = threadIdx.x; asm volatile("" : "+v"(tid));
    const int wid = __builtin_amdgcn_readfirstlane(tid >> 6), lane = tid & 63, wr = wid >> 2, wc = wid & 3, fr = lane & 15, fq = lane >> 4;
    const unsigned ldsw = (unsigned)wid * 1024u;
    const int aoff = lds_byte(wr * 64 + fr, fq * 8), boff = lds_byte(wc * 32 + fr, fq * 8);
#define PG8_SA(b, h) (((b) * 2 + (h)) * HTB)
#define PG8_SB(b, h) ((4 + (b) * 2 + (h)) * HTB)
#define PG8_STAGE(bufoff, gbase, voff) do { _Pragma("unroll") for (int _i = 0; _i < 2; ++_i) \
        __builtin_amdgcn_global_load_lds((const unsigned*)((const char*)(gbase) + (voff)[_i]), (LAS unsigned*)(lds + (bufoff) + ldsw + _i * 8192), 16, 0, 0); } while (0)
#define PG8_LDA(dst, b, h) do { _Pragma("unroll") for (int m = 0; m < 4; ++m) _Pragma("unroll") for (int k = 0; k < 2; ++k) dst[m][k] = *(const LAS bf16x8*)(lds + PG8_SA(b, h) + aoff + m * 2048 + k * 1024); } while (0)
#define PG8_LDB(dst, b, h) do { _Pragma("unroll") for (int n = 0; n < 2; ++n) _Pragma("unroll") for (int k = 0; k < 2; ++k) dst[n][k] = *(const LAS bf16x8*)(lds + PG8_SB(b, h) + boff + n * 2048 + k * 1024); } while (0)
#define PG8_MMA(ai, bj, At, Bt) do { __builtin_amdgcn_s_setprio(1); _Pragma("unroll") for (int m = 0; m < 4; ++m) _Pragma("unroll") for (int n = 0; n < 2; ++n) _Pragma("unroll") for (int k = 0; k < 2; ++k) \
        acc[ai][bj][m][n] = __builtin_amdgcn_mfma_f32_16x16x32_bf16(Bt[n][k], At[m][k], acc[ai][bj][m][n], 0, 0, 0); __builtin_amdgcn_s_setprio(0); } while (0)
#define PG8_WAIT_V(n) asm volatile("s_waitcnt vmcnt(" #n ")" ::: "memory")
#define PG8_WAIT_L(n) asm volatile("s_waitcnt lgkmcnt(" #n ")" ::: "memory")
#define PG8_BAR __builtin_amdgcn_s_barrier()
#define PG8_SCHED __builtin_amdgcn_sched_barrier(0)
    GUnit cur, nxt; int ui = 0;
    if (!S.next(0, cur)) return;
    f32x4 acc[2][2][4][2];
#pragma unroll
    for (int a = 0; a < 2; ++a)
#pragma unroll
        for (int b = 0; b < 2; ++b)
#pragma unroll
            for (int m = 0; m < 4; ++m)
#pragma unroll
                for (int n = 0; n < 2; ++n) acc[a][b][m][n] = (f32x4){0.f, 0.f, 0.f, 0.f};
    bf16x8 At[4][2], B0[2][2], B1[2][2];
    constexpr bool GA = Sched::GATHER;
#define PG8_STA(bufoff, U, h, koff) do { if constexpr (GA) { if ((h) == 0) PG8_STAGE(bufoff, (U).a + (koff), (U).offA); else PG8_STAGE(bufoff, (U).a + (koff), (U).offA1); } \
        else PG8_STAGE(bufoff, (U).a + (koff) + (size_t)((h) * (U).hsA), (U).offA); } while (0)
#define PG8_STB(bufoff, U, h, koff) PG8_STAGE(bufoff, (U).b + (koff) + (size_t)((h) * (U).hsB), (U).offB)
    PG8_STB(PG8_SB(0, 0), cur, 0, 0); PG8_STB(PG8_SB(0, 1), cur, 1, 0); PG8_STA(PG8_SA(0, 0), cur, 0, 0); PG8_STA(PG8_SA(0, 1), cur, 1, 0);
    if (wr == 1) PG8_BAR;
    PG8_WAIT_V(2); PG8_BAR;
    PG8_STB(PG8_SB(1, 0), cur, 0, 128); PG8_STA(PG8_SA(1, 0), cur, 0, 128); PG8_STB(PG8_SB(1, 1), cur, 1, 128);
    PG8_WAIT_V(6); PG8_BAR;
    for (;;) {
        const bool has_next = S.next(ui + 1, nxt);
        if (!has_next) nxt = cur;
        const int nt = cur.nt;
        for (int t = 0; t < nt; t += 2) {
            const bool last = (t == nt - 2);
            const size_t k1 = (size_t)(t + 1) * 128;
            GUnit sel;
            sel.a = last ? nxt.a : cur.a + (size_t)(t + 2) * 128; sel.b = last ? nxt.b : cur.b + (size_t)(t + 2) * 128;
            sel.hsA = last ? nxt.hsA : cur.hsA; sel.hsB = last ? nxt.hsB : cur.hsB;
#pragma unroll
            for (int i = 0; i < 2; ++i) { sel.offA[i] = last ? nxt.offA[i] : cur.offA[i]; sel.offB[i] = last ? nxt.offB[i] : cur.offB[i]; if constexpr (GA) sel.offA1[i] = last ? nxt.offA1[i] : cur.offA1[i]; }
            PG8_LDB(B0, 0, 0); PG8_LDB(B1, 0, 1); PG8_SCHED; PG8_LDA(At, 0, 0); PG8_STA(PG8_SA(1, 1), cur, 1, k1);
            PG8_WAIT_V(8); PG8_WAIT_L(0); PG8_BAR; PG8_MMA(0, 0, At, B0); PG8_MMA(0, 1, At, B1); PG8_BAR; PG8_SCHED;
            PG8_LDA(At, 0, 1); PG8_STB(PG8_SB(0, 0), sel, 0, 0); PG8_STB(PG8_SB(0, 1), sel, 1, 0); PG8_STA(PG8_SA(0, 0), sel, 0, 0);
            PG8_WAIT_V(8); PG8_WAIT_L(0); PG8_BAR; PG8_MMA(1, 0, At, B0); PG8_MMA(1, 1, At, B1); PG8_BAR; PG8_SCHED;
            PG8_LDB(B0, 1, 0); PG8_LDB(B1, 1, 1); PG8_SCHED; PG8_LDA(At, 1, 0); PG8_STA(PG8_SA(0, 1), sel, 1, 0);
            PG8_WAIT_V(8); PG8_WAIT_L(0); PG8_BAR; PG8_MMA(0, 0, At, B0); PG8_MMA(0, 1, At, B1); PG8_BAR; PG8_SCHED;
            PG8_LDA(At, 1, 1); PG8_STB(PG8_SB(1, 0), sel, 0, 128); PG8_STB(PG8_SB(1, 1), sel, 1, 128); PG8_STA(PG8_SA(1, 0), sel, 0, 128);
            PG8_WAIT_V(8); PG8_WAIT_L(0); PG8_BAR; PG8_MMA(1, 0, At, B0); PG8_MMA(1, 1, At, B1); PG8_BAR; PG8_SCHED;
        }
        if constexpr (ALIGN_EPI) { if (wr == 0) PG8_BAR; }
        E(acc, cur, wr, wc, fr, fq);
        if (!has_next) break;
#pragma unroll
        for (int a = 0; a < 2; ++a)
#pragma unroll
            for (int b = 0; b < 2; ++b)
#pragma unroll
                for (int m = 0; m < 4; ++m)
#pragma unroll
                    for (int n = 0; n < 2; ++n) acc[a][b][m][n] = (f32x4){0.f, 0.f, 0.f, 0.f};
        cur = nxt; ++ui;
        if constexpr (ALIGN_EPI) { if (wr == 1) PG8_BAR; }
    }
    PG8_WAIT_V(0);
    if constexpr (!ALIGN_EPI) { if (wr == 0) PG8_BAR; }
    PG8_BAR;
#undef PG8_SA
#undef PG8_SB
#undef PG8_STAGE
#undef PG8_STA
#undef PG8_STB
#undef PG8_LDA
#undef PG8_LDB
#undef PG8_MMA
#undef PG8_WAIT_V
#undef PG8_WAIT_L
#undef PG8_BAR
#undef PG8_SCHED
}

__device__ __forceinline__ void tile_of(int wgid, int nM, int nN, int& pm, int& pn) {
    const int WGM = 8, nig = WGM * nN, gid = wgid / nig, fm = gid * WGM, gsz = (nM - fm) < WGM ? (nM - fm) : WGM;
    pm = fm + ((wgid % nig) % gsz); pn = (wgid % nig) / gsz;
}
__device__ __forceinline__ void dense_offsets(GUnit& u, const LaneGeom& g, int lda_bytes, int ldb_bytes, bool perm) {
    u.hsA = 128 * lda_bytes; u.hsB = 128 * ldb_bytes;
#pragma unroll
    for (int i = 0; i < 2; ++i) {
        u.offA[i] = (unsigned)(g.R[i] * lda_bytes + g.C[i] * 2); u.offA1[i] = 0u;
        u.offB[i] = (unsigned)((perm ? g.Rp[i] : g.R[i]) * ldb_bytes + g.C[i] * 2);
    }
}
}
using pg8::GUnit; using pg8::LaneGeom;

struct Params {
    const float* x; const float* mem; const int* positions;
    const float* w_in; const float* w_mem_kv; const float* w_gate; const float* b_gate;
    const float* w_br_dil; const float* w_br_moba; const float* w_br_mem; const float* w_out;
    const float* ln1_g; const float* ln1_b; const float* w_router; const float* router_bias;
    const float* w_e_gate; const float* w_e_up; const float* w_e_down;
    const float* w_s_gate; const float* w_s_up; const float* w_s_down; const float* ln2_g; const float* ln2_b;
    float* out; unsigned char* ws;
};

__device__ __forceinline__ void transpose_item(const float* W, int N, bf16_t* WT, int dld, int k0, int n0, int drow0, LAS float* scr, int lane) {
#pragma unroll 8
    for (int i = 0; i < 32; ++i) { const int kk = 2 * i + (lane >> 5); scr[kk * 33 + (lane & 31)] = W[(size_t)(k0 + kk) * N + n0 + (lane & 31)]; }
    LDS_WAIT(); asm volatile("" ::: "memory");
    const int c = lane & 7;
#pragma unroll
    for (int j = 0; j < 4; ++j) { const int n = (lane >> 3) + 8 * j; const LAS float* s = scr + (8 * c) * 33 + n;
        u32x4 o; o.x = cvtpk(s[0 * 33], s[1 * 33]); o.y = cvtpk(s[2 * 33], s[3 * 33]); o.z = cvtpk(s[4 * 33], s[5 * 33]); o.w = cvtpk(s[6 * 33], s[7 * 33]);
        *(u32x4*)(WT + (size_t)(drow0 + n) * dld + k0 + 8 * c) = o; }
    LDS_WAIT(); asm volatile("" ::: "memory");
}
__device__ __forceinline__ bool p0_seg(int& r, const float* W, int K, int N, bf16_t* WT, int dld, int mode  , int row_off, LAS float* scr, int lane) {
    const int nblk = N / 32, items = (K / 64) * nblk;
    if (r >= items) { r -= items; return false; }
    const int kb = r / nblk, nb = r % nblk, n0 = 32 * nb;
    const int drow0 = row_off + (mode == 0 ? n0 : 256 * (n0 >> 7) + (n0 & 127) + (mode == 2 ? 128 : 0));
    transpose_item(W, N, WT, dld, 64 * kb, n0, drow0, scr, lane);
    return true;
}
__device__ __forceinline__ void p0_prologue(const Params& P, LAS unsigned char* lds, int gw, int NGW, int gtid, int NTHR, int lane, int wave) {
    unsigned char* ws = P.ws;
    LAS float* scr = (LAS float*)(lds + wave * 16384);
    constexpr int SMALL_ITEMS = 1280 + 1536 + 256 + 64 + 192 + 128 + 512 + 128 + 128 + 128 + 128;
    constexpr int EXP_ITEMS = 128;
    constexpr int NITEMS = SMALL_ITEMS + 3 * NEXP * EXP_ITEMS;
    for (int it = gw; it < NITEMS; it += NGW) {
        int r = it;
        if (r < SMALL_ITEMS) {
            if (p0_seg(r, P.w_in, 1024, WIN, (bf16_t*)(ws + WS_WTQG), 1024, 0, 0, scr, lane)) continue;
            if (p0_seg(r, P.w_gate, 1024, NGATE, (bf16_t*)(ws + WS_WTQG), 1024, 0, WIN, scr, lane)) continue;
            if (p0_seg(r, P.w_mem_kv, 1024, 512, (bf16_t*)(ws + WS_WTKV), 1024, 0, 0, scr, lane)) continue;
            if (p0_seg(r, P.w_br_dil, 128, 1024, (bf16_t*)(ws + WS_WTBRD), 128, 0, 0, scr, lane)) continue;
            if (p0_seg(r, P.w_br_moba, 384, 1024, (bf16_t*)(ws + WS_WTBRM), 384, 0, 0, scr, lane)) continue;
            if (p0_seg(r, P.w_br_mem, 256, 1024, (bf16_t*)(ws + WS_WTBRX), 256, 0, 0, scr, lane)) continue;
            if (p0_seg(r, P.w_out, 1024, 1024, (bf16_t*)(ws + WS_WTOUT), 1024, 0, 0, scr, lane)) continue;
            if (p0_seg(r, P.w_router, 1024, 256, (bf16_t*)(ws + WS_WTRS), 1024, 0, 0, scr, lane)) continue;
            if (p0_seg(r, P.w_s_gate, 1024, 256, (bf16_t*)(ws + WS_WTRS), 1024, 1, 256, scr, lane)) continue;
            if (p0_seg(r, P.w_s_up, 1024, 256, (bf16_t*)(ws + WS_WTRS), 1024, 2, 256, scr, lane)) continue;
            p0_seg(r, P.w_s_down, 256, 1024, (bf16_t*)(ws + WS_WTSD), 256, 0, 0, scr, lane);
        } else {
            r -= SMALL_ITEMS;
            const int which = r / (NEXP * EXP_ITEMS); r -= which * (NEXP * EXP_ITEMS);
            const int e = r / EXP_ITEMS; r -= e * EXP_ITEMS;
            if (which == 0) p0_seg(r, P.w_e_gate + (size_t)e * 1024 * 256, 1024, 256, (bf16_t*)(ws + WS_W1T) + (size_t)e * 512 * 1024, 1024, 1, 0, scr, lane);
            else if (which == 1) p0_seg(r, P.w_e_up + (size_t)e * 1024 * 256, 1024, 256, (bf16_t*)(ws + WS_W1T) + (size_t)e * 512 * 1024, 1024, 2, 0, scr, lane);
            else p0_seg(r, P.w_e_down + (size_t)e * 256 * 1024, 256, 1024, (bf16_t*)(ws + WS_W2T) + (size_t)e * 1024 * 256, 256, 0, 0, scr, lane);
        }
    }
    for (int c = gtid; c < NTOK * DM / 8; c += NTHR) { const f32x4 a = *(const f32x4*)(P.x + (size_t)c * 8), b = *(const f32x4*)(P.x + (size_t)c * 8 + 4); *(u32x4*)((bf16_t*)(ws + WS_XB) + (size_t)c * 8) = pack8(a, b); }
    for (int c = gtid; c < 2048 * DM / 8; c += NTHR) { const f32x4 a = *(const f32x4*)(P.mem + (size_t)c * 8), b = *(const f32x4*)(P.mem + (size_t)c * 8 + 4); *(u32x4*)((bf16_t*)(ws + WS_MEMB) + (size_t)c * 8) = pack8(a, b); }
    for (int tkn = gtid; tkn < NTOK; tkn += NTHR) {
        const double p = (double)P.positions[tkn]; float* o = (float*)(ws + WS_ROPE) + (size_t)tkn * 16;
#define ROPE_J(j, f) { const double a = p * (double)(f); const double rv = a * 0.15915494309189535; const double fr_ = rv - __builtin_rint(rv); const float ang = (float)(fr_ * 6.283185307179586); o[j] = cosf(ang); o[8 + j] = sinf(ang); }
        ROPE_J(0, 1.0f) ROPE_J(1, 0.1939227432012558f) ROPE_J(2, 0.03760603070259094f) ROPE_J(3, 0.007292664609849453f)
        ROPE_J(4, 0.0014142135623842478f) ROPE_J(5, 0.00027424818836152554f) ROPE_J(6, 5.318296098266728e-05f) ROPE_J(7, 1.0313386155758053e-05f)
#undef ROPE_J
    }
    unsigned* ctl = (unsigned*)(ws + WS_CTL);
    for (int i = gtid; i < 8192 + 49152; i += NTHR) ctl[i] = 0u;
}

struct SchedP1 {
    static constexpr bool GATHER = false;
    LaneGeom g; int G, c; const unsigned char* ws;
    __device__ __forceinline__ bool next(int i, GUnit& u) const {
        const int L = i * G + c; if (L >= 2816 + 16) return false;
        if (L < 2816) { const int wgid = pg8::xcd_remap(L, 2816); pg8::tile_of(wgid, 128, 22, u.pm, u.pn);
            u.a = (const char*)(ws + WS_XB) + (size_t)u.pm * 256 * 2048; u.b = (const char*)(ws + WS_WTQG) + (size_t)u.pn * 256 * 2048; u.kind = u.pn < 10 ? 0 : 1; }
        else { const int j = L - 2816; u.pm = j >> 1; u.pn = j & 1; u.kind = 2;
            u.a = (const char*)(ws + WS_MEMB) + (size_t)u.pm * 256 * 2048; u.b = (const char*)(ws + WS_WTKV) + (size_t)u.pn * 256 * 2048; }
        u.nt = 16; u.aux = 0; pg8::dense_offsets(u, g, 2048, 2048, true); return true;
    }
};
struct EpiP1 {
    bf16_t* qkv; bf16_t* gates; bf16_t* kvm; const float* bgate; const float* rope; float* ksum;
    __device__ __forceinline__ void operator()(const f32x4 (&acc)[2][2][4][2], const GUnit& u, int wr, int wc, int fr, int fq) const {
        const int row0 = u.pm * 256 + wr * 64 + fr;
        if (u.kind == 0) {
            const int cb0 = u.pn * 256 + 32 * wc;
            const bool even = (wc & 1) == 0;
            const int head0 = cb0 >> 6, head1 = (cb0 + 128) >> 6;
            const bool rh0 = head0 < 12 || (head0 >= 18 && head0 < 30), rh1 = head1 < 12 || (head1 >= 18 && head1 < 30);
            const bool anyrot = even && (rh0 || rh1);
            f32x4 cs0[2] = {{0.f, 0.f, 0.f, 0.f}, {0.f, 0.f, 0.f, 0.f}}, cs1[2] = {{0.f, 0.f, 0.f, 0.f}, {0.f, 0.f, 0.f, 0.f}};
#pragma unroll
            for (int ai = 0; ai < 2; ++ai) {
                f32x4 rc[4][4];
                if (anyrot) {
#pragma unroll
                    for (int m = 0; m < 4; ++m) { const float* rp = rope + (size_t)(row0 + 128 * ai + 16 * m) * 16;
#pragma unroll
                        for (int q = 0; q < 4; ++q) rc[m][q] = *(const f32x4*)(rp + 4 * q); }
                    asm volatile("" ::: "memory");
                }
#pragma unroll
                for (int bj = 0; bj < 2; ++bj) {
                    const int colbase = cb0 + 128 * bj, head = bj == 0 ? head0 : head1;
                    const bool rot = even && (bj == 0 ? rh0 : rh1);
                    const bool qhead = head < 6 || (head >= 18 && head < 24) || head >= 36;
                    const bool khead = head >= 24 && head < 30;
                    const float sc = qhead ? C2 : 1.0f;
#pragma unroll
                    for (int m = 0; m < 4; ++m) {
                        const int row = row0 + 128 * ai + 16 * m;
                        f32x4 v0 = acc[ai][bj][m][0], v1 = acc[ai][bj][m][1];
                        if (rot) {
                            f32x4 p0, p1;
#pragma unroll
                            for (int e = 0; e < 4; ++e) { p0[e] = __shfl_xor(v0[e], 16); p1[e] = __shfl_xor(v1[e], 16); }
                            if (fq == 0) { v0 = v0 * rc[m][0] - p0 * rc[m][2]; v1 = v1 * rc[m][1] - p1 * rc[m][3]; }
                            else if (fq == 1) { v0 = v0 * rc[m][0] + p0 * rc[m][2]; v1 = v1 * rc[m][1] + p1 * rc[m][3]; }
                        }
                        v0 = v0 * sc; v1 = v1 * sc;
                        if (khead) { cs0[bj] += v0; cs1[bj] += v1; }
                        *(u32x4*)(qkv + (size_t)row * WIN + colbase + 8 * fq) = pack8(v0, v1);
                    }
                }
            }
#pragma unroll
            for (int bj = 0; bj < 2; ++bj) {
                const int colbase = cb0 + 128 * bj, head = bj == 0 ? head0 : head1;
                if (head >= 24 && head < 30) {
                    f32x4 a = cs0[bj], b = cs1[bj];
#pragma unroll
                    for (int e = 0; e < 4; ++e) {
#pragma unroll
                        for (int o = 1; o < 16; o <<= 1) { a[e] += __shfl_xor(a[e], o); b[e] += __shfl_xor(b[e], o); }
                    }
                    if (fr == 0) { float* kp = ksum + ((size_t)u.pm * 6 + (head - 24)) * 64 + (colbase & 63) + 8 * fq;
#pragma unroll
                        for (int e = 0; e < 4; ++e) { atomicAdd(kp + e, a[e]); atomicAdd(kp + 4 + e, b[e]); } }
                }
            }
        } else if (u.kind == 1) {
#pragma unroll
            for (int bj = 0; bj < 2; ++bj) {
                const int col = (u.pn - 10) * 256 + 128 * bj + 32 * wc + 8 * fq;
                const f32x4 b0 = *(const f32x4*)(bgate + col), b1 = *(const f32x4*)(bgate + col + 4);
#pragma unroll
                for (int ai = 0; ai < 2; ++ai)
#pragma unroll
                    for (int m = 0; m < 4; ++m) {
                        const int row = row0 + 128 * ai + 16 * m;
                        f32x4 v0 = acc[ai][bj][m][0] + b0, v1 = acc[ai][bj][m][1] + b1;
#pragma unroll
                        for (int e = 0; e < 4; ++e) { v0[e] = fast_sigmoid(v0[e]); v1[e] = fast_sigmoid(v1[e]); }
                        *(u32x4*)(gates + (size_t)row * NGATE + col) = pack8(v0, v1);
                    }
            }
        } else {
#pragma unroll
            for (int bj = 0; bj < 2; ++bj) {
                const int col = u.pn * 256 + 128 * bj + 32 * wc + 8 * fq;
#pragma unroll
                for (int ai = 0; ai < 2; ++ai)
#pragma unroll
                    for (int m = 0; m < 4; ++m) { const int row = row0 + 128 * ai + 16 * m; *(u32x4*)(kvm + (size_t)row * 512 + col) = pack8(acc[ai][bj][m][0], acc[ai][bj][m][1]); }
            }
        }
    }
};

struct SchedP3 {
    static constexpr bool GATHER = false;
    LaneGeom g; int G, c; const unsigned char* ws;
    __device__ __forceinline__ bool next(int i, GUnit& u) const {
        const int i3 = i / 3, br = i - 3 * i3; const int L = i3 * G + c; if (L >= 512) return false;
        const int wgid = pg8::xcd_remap(L, 512); pg8::tile_of(wgid, 128, 4, u.pm, u.pn);
        u.kind = br; u.aux = 0;
        int kb; size_t abase, bbase;
        if (br == 0) { kb = 128; abase = WS_YDIL; bbase = WS_WTBRD; } else if (br == 1) { kb = 384; abase = WS_YMOBA; bbase = WS_WTBRM; } else { kb = 256; abase = WS_YMEM; bbase = WS_WTBRX; }
        u.nt = kb / 64;
        u.a = (const char*)(ws + abase) + (size_t)u.pm * 256 * kb * 2; u.b = (const char*)(ws + bbase) + (size_t)u.pn * 256 * kb * 2;
        pg8::dense_offsets(u, g, kb * 2, kb * 2, true); return true;
    }
};
struct EpiP3 {
    const bf16_t* gates; bf16_t* merged;
    __device__ __forceinline__ void operator()(const f32x4 (&acc)[2][2][4][2], const GUnit& u, int wr, int wc, int fr, int fq) const {
        const int row0 = u.pm * 256 + wr * 64 + fr, col0 = u.pn * 256 + 32 * wc + 8 * fq;
#pragma unroll
        for (int ai = 0; ai < 2; ++ai) {
            u32x4 gv[4][2], ov[4][2];
#pragma unroll
            for (int m = 0; m < 4; ++m)
#pragma unroll
                for (int bj = 0; bj < 2; ++bj) { const size_t row = (size_t)(row0 + 128 * ai + 16 * m);
                    gv[m][bj] = *(const u32x4*)(gates + row * NGATE + u.kind * 1024 + col0 + 128 * bj);
                    ov[m][bj] = u.kind != 0 ? *(const u32x4*)(merged + row * DM + col0 + 128 * bj) : (u32x4){0u, 0u, 0u, 0u}; }
            asm volatile("" ::: "memory");
#pragma unroll
            for (int m = 0; m < 4; ++m)
#pragma unroll
                for (int bj = 0; bj < 2; ++bj) { const size_t row = (size_t)(row0 + 128 * ai + 16 * m);
                    f32x4 g0, g1, o0, o1; unpack8(gv[m][bj], g0, g1); unpack8(ov[m][bj], o0, o1);
                    *(u32x4*)(merged + row * DM + col0 + 128 * bj) = pack8(o0 + g0 * acc[ai][bj][m][0], o1 + g1 * acc[ai][bj][m][1]); }
            asm volatile("" ::: "memory");
        }
    }
};

struct SchedP4 {
    static constexpr bool GATHER = false;
    LaneGeom g; int G, c; const unsigned char* ws;
    __device__ __forceinline__ bool next(int i, GUnit& u) const {
        const int L = i * G + c; if (L >= 512) return false;
        const int wgid = pg8::xcd_remap(L, 512); pg8::tile_of(wgid, 128, 4, u.pm, u.pn);
        u.kind = 0; u.aux = 0; u.nt = 16;
        u.a = (const char*)(ws + WS_MERGED) + (size_t)u.pm * 256 * 2048; u.b = (const char*)(ws + WS_WTOUT) + (size_t)u.pn * 256 * 2048;
        pg8::dense_offsets(u, g, 2048, 2048, false); return true;
    }
};
struct EpiP4 {
    const float* x; float* h1;
    __device__ __forceinline__ void operator()(const f32x4 (&acc)[2][2][4][2], const GUnit& u, int wr, int wc, int fr, int fq) const {
        const int row0 = u.pm * 256 + wr * 64 + fr, col0 = u.pn * 256 + wc * 32 + 4 * fq;
#pragma unroll
        for (int ai = 0; ai < 2; ++ai) {
            f32x4 xv[4][2][2];
#pragma unroll
            for (int m = 0; m < 4; ++m) { const size_t off = (size_t)(row0 + 128 * ai + 16 * m) * DM + col0;
#pragma unroll
                for (int bj = 0; bj < 2; ++bj)
#pragma unroll
                    for (int n = 0; n < 2; ++n) xv[m][bj][n] = *(const f32x4*)(x + off + bj * 128 + n * 16); }
            asm volatile("" ::: "memory");
#pragma unroll
            for (int m = 0; m < 4; ++m) { const size_t off = (size_t)(row0 + 128 * ai + 16 * m) * DM + col0;
#pragma unroll
                for (int bj = 0; bj < 2; ++bj)
#pragma unroll
                    for (int n = 0; n < 2; ++n) *(f32x4*)(h1 + off + bj * 128 + n * 16) = xv[m][bj][n] * ALPHA + acc[ai][bj][m][n]; }
            asm volatile("" ::: "memory");
        }
    }
};

struct SchedP6 {
    static constexpr bool GATHER = false;
    LaneGeom g; int G, c; const unsigned char* ws;
    __device__ __forceinline__ bool next(int i, GUnit& u) const {
        const int L = i * G + c; if (L >= 384) return false;
        const int wgid = pg8::xcd_remap(L, 384); pg8::tile_of(wgid, 128, 3, u.pm, u.pn);
        u.kind = u.pn == 0 ? 0 : 1; u.aux = 0; u.nt = 16;
        u.a = (const char*)(ws + WS_X1B) + (size_t)u.pm * 256 * 2048; u.b = (const char*)(ws + WS_WTRS) + (size_t)u.pn * 256 * 2048;
        pg8::dense_offsets(u, g, 2048, 2048, u.pn != 0); return true;
    }
};
__device__ __forceinline__ void swiglu_store(const f32x4 (&acc)[2][2][4][2], bf16_t* hid, size_t row_base  , int hcol0, int wr, int wc, int fr, int fq) {
#pragma unroll
    for (int ai = 0; ai < 2; ++ai)
#pragma unroll
        for (int m = 0; m < 4; ++m) {
            const size_t row = row_base + 128 * ai + 64 * wr + 16 * m + fr;
            f32x4 h0, h1;
#pragma unroll
            for (int e = 0; e < 4; ++e) { const float g0 = acc[ai][0][m][0][e], g1 = acc[ai][0][m][1][e];
                h0[e] = g0 * fast_sigmoid(g0) * acc[ai][1][m][0][e]; h1[e] = g1 * fast_sigmoid(g1) * acc[ai][1][m][1][e]; }
            *(u32x4*)(hid + row * 256 + hcol0 + 32 * wc + 8 * fq) = pack8(h0, h1);
        }
}
struct EpiP6 {
    float* scores; bf16_t* hids;
    __device__ __forceinline__ void operator()(const f32x4 (&acc)[2][2][4][2], const GUnit& u, int wr, int wc, int fr, int fq) const {
        if (u.kind == 0) {
            const int row0 = u.pm * 256 + wr * 64 + fr, col0 = wc * 32 + 4 * fq;
#pragma unroll
            for (int ai = 0; ai < 2; ++ai)
#pragma unroll
                for (int m = 0; m < 4; ++m) { const size_t off = (size_t)(row0 + 128 * ai + 16 * m) * 256 + col0;
#pragma unroll
                    for (int bj = 0; bj < 2; ++bj)
#pragma unroll
                        for (int n = 0; n < 2; ++n) { f32x4 v = acc[ai][bj][m][n];
#pragma unroll
                            for (int e = 0; e < 4; ++e) v[e] = 1.0f / (1.0f + __expf(-v[e]));
                            *(f32x4*)(scores + off + bj * 128 + n * 16) = v; } }
        } else swiglu_store(acc, hids, (size_t)u.pm * 256, 128 * (u.pn - 1), wr, wc, fr, fq);
    }
};

struct SchedP9 {
    static constexpr bool GATHER = true;
    LaneGeom g; int G, c; const unsigned char* ws; int nwg;
    __device__ __forceinline__ bool next(int i, GUnit& u) const {
        const int L = i * G + c; if (L >= nwg) return false;
        const int wgid = pg8::xcd_remap(L, nwg); const int rt = wgid >> 1, p = wgid & 1;
        const int e = ((const int*)(ws + WS_CTL))[CW_TILEE + rt];
        u.pm = rt; u.pn = p; u.kind = 0; u.aux = e; u.nt = 16;
        u.a = (const char*)(ws + WS_X1B); u.b = (const char*)(ws + WS_W1T) + (size_t)e * (512 * 2048) + (size_t)p * 256 * 2048;
        const int* rtok = (const int*)(ws + WS_ROWTOK) + (size_t)rt * 256;
        u.hsA = 0; u.hsB = 128 * 2048;
#pragma unroll
        for (int k = 0; k < 2; ++k) { u.offA[k] = (unsigned)rtok[g.R[k]] * 2048u + (unsigned)(g.C[k] * 2); u.offA1[k] = (unsigned)rtok[128 + g.R[k]] * 2048u + (unsigned)(g.C[k] * 2); u.offB[k] = (unsigned)(g.Rp[k] * 2048 + g.C[k] * 2); }
        return true;
    }
};
struct EpiP9 {
    bf16_t* hid;
    __device__ __forceinline__ void operator()(const f32x4 (&acc)[2][2][4][2], const GUnit& u, int wr, int wc, int fr, int fq) const { swiglu_store(acc, hid, (size_t)u.pm * 256, 128 * u.pn, wr, wc, fr, fq); }
};

__device__ __forceinline__ bf16_t* y_row(unsigned char* ws, int r) { return r < Y_SPLIT ? (bf16_t*)(ws + WS_Y1) + (size_t)r * DM : (bf16_t*)(ws + WS_Y2) + (size_t)(r - Y_SPLIT) * DM; }
struct SchedP10 {
    static constexpr bool GATHER = false;
    LaneGeom g; int G, c; const unsigned char* ws; int nwg;
    __device__ __forceinline__ bool next(int i, GUnit& u) const {
        const int L = i * G + c; if (L >= nwg) return false;
        u.nt = 4; u.aux = 0;
        const int wgid = pg8::xcd_remap(L, nwg); const int rt = wgid >> 2, pn = wgid & 3;
        const int e = ((const int*)(ws + WS_CTL))[CW_TILEE + rt];
        u.pm = rt; u.pn = pn; u.kind = 0;
        u.a = (const char*)(ws + WS_HID) + (size_t)rt * 256 * 512; u.b = (const char*)(ws + WS_W2T) + (size_t)e * (1024 * 512) + (size_t)pn * 256 * 512;
        pg8::dense_offsets(u, g, 512, 512, true);
        return true;
    }
};
struct EpiP10 {
    unsigned char* ws; const int* row_y; const float* row_w;
    __device__ __forceinline__ void operator()(const f32x4 (&acc)[2][2][4][2], const GUnit& u, int wr, int wc, int fr, int fq) const {
        int ry[2][4]; float rw[2][4];
#pragma unroll
        for (int ai = 0; ai < 2; ++ai)
#pragma unroll
            for (int m = 0; m < 4; ++m) { const int d = u.pm * 256 + 128 * ai + 64 * wr + 16 * m + fr; ry[ai][m] = row_y[d]; rw[ai][m] = row_w[d]; }
        asm volatile("" ::: "memory");
#pragma unroll
        for (int ai = 0; ai < 2; ++ai)
#pragma unroll
            for (int m = 0; m < 4; ++m) {
                if (ry[ai][m] >= 0) { bf16_t* yp = y_row(ws, ry[ai][m]) + u.pn * 256 + 32 * wc + 8 * fq; const float w = rw[ai][m];
#pragma unroll
                    for (int bj = 0; bj < 2; ++bj) *(u32x4*)(yp + 128 * bj) = pack8(acc[ai][bj][m][0] * w, acc[ai][bj][m][1] * w); }
            }
    }
};
struct SchedP10s {
    static constexpr bool GATHER = false;
    LaneGeom g; int G, c; const unsigned char* ws; int shift;
    __device__ __forceinline__ bool next(int i, GUnit& u) const {
        const int L = i * G + ((c + shift) % G); if (L >= 512) return false;
        u.nt = 4; u.aux = 0; u.kind = 1;
        const int wgid = pg8::xcd_remap(L, 512); pg8::tile_of(wgid, 128, 4, u.pm, u.pn);
        u.a = (const char*)(ws + WS_HIDS) + (size_t)u.pm * 256 * 512; u.b = (const char*)(ws + WS_WTSD) + (size_t)u.pn * 256 * 512;
        pg8::dense_offsets(u, g, 512, 512, false);
        return true;
    }
};
struct EpiP10s {
    float* x1f; float* xo;
    __device__ __forceinline__ void operator()(const f32x4 (&acc)[2][2][4][2], const GUnit& u, int wr, int wc, int fr, int fq) const {
        const int row0 = u.pm * 256 + wr * 64 + fr, col0 = u.pn * 256 + wc * 32 + 4 * fq;
#pragma unroll
        for (int ai = 0; ai < 2; ++ai) {
            f32x4 xv[4][2][2];
#pragma unroll
            for (int m = 0; m < 4; ++m) { const size_t off = (size_t)(row0 + 128 * ai + 16 * m) * DM + col0;
#pragma unroll
                for (int bj = 0; bj < 2; ++bj)
#pragma unroll
                    for (int n = 0; n < 2; ++n) xv[m][bj][n] = *(const f32x4*)(x1f + off + bj * 128 + n * 16); }
            asm volatile("" ::: "memory");
#pragma unroll
            for (int m = 0; m < 4; ++m) { const size_t off = (size_t)(row0 + 128 * ai + 16 * m) * DM + col0;
#pragma unroll
                for (int bj = 0; bj < 2; ++bj)
#pragma unroll
                    for (int n = 0; n < 2; ++n) *(f32x4*)(xo + off + bj * 128 + n * 16) = xv[m][bj][n] * ALPHA + acc[ai][bj][m][n]; }
            asm volatile("" ::: "memory");
        }
    }
};

namespace att {
constexpr int SLOTB = 8192, LDS_K = 0, LDS_V = 2 * SLOTB, LDS_WS = 4 * SLOTB, LDS_OST = LDS_WS + 8 * 256, LDS_BYTES = LDS_OST + 8 * 4096;
typedef short v4i16_t __attribute__((ext_vector_type(4)));
__device__ __forceinline__ int crow(int r, int hi) { return (r & 3) + 8 * (r >> 2) + 4 * hi; }
__device__ __forceinline__ void glds16(const void* gsrc, unsigned lds_dst) { unsigned keep;
    asm volatile("s_mov_b32 %0, m0\n\ts_mov_b32 m0, %2\n\ts_nop 0\n\tglobal_load_lds_dwordx4 %1, off\n\ts_mov_b32 m0, %0" : "=&s"(keep) : "v"(gsrc), "s"(lds_dst) : "memory"); }
__device__ __forceinline__ s16x4 vtr(LAS const char* p) { return __builtin_bit_cast(s16x4, __builtin_amdgcn_ds_read_tr16_b64_v4i16((LAS v4i16_t*)p)); }
__device__ __forceinline__ float rowmax32(const f32x16& p0, const f32x16& p1) {
    float a = p0[0];
#pragma unroll
    for (int r = 1; r < 16; ++r) a = __builtin_fmaxf(a, p0[r]);
#pragma unroll
    for (int r = 0; r < 16; ++r) a = __builtin_fmaxf(a, p1[r]);
    auto rr = __builtin_amdgcn_permlane32_swap(__float_as_uint(a), __float_as_uint(a), false, false);
    return __builtin_fmaxf(__uint_as_float(rr[0]), __uint_as_float(rr[1]));
}
struct Desc {
    const bf16_t* q; long qs;
    const bf16_t* k; const bf16_t* v; long kvs; int key0;
    bf16_t* o; long os;
    float* lse; long lses;
    int nt;
    int mode;
    int qb;
    const float* ksum;
};
template <int MODE>
__device__ __forceinline__ void attn_unit(LAS char* shm, const Desc& D) {
    int tid = threadIdx.x; asm volatile("" : "+v"(tid));
    const int lane = tid & 63, r32 = lane & 31, hi = lane >> 5; const int wid = __builtin_amdgcn_readfirstlane(tid >> 6);
    const unsigned lds0 = (unsigned)(uintptr_t)shm;
    LAS float* wsf = (LAS float*)(shm + LDS_WS) + wid * 64;
    const bf16_t* Qw = D.q + (long)(wid * 32 + r32) * D.qs;
    bf16x8 qr[4];
#pragma unroll
    for (int d0 = 0; d0 < 4; ++d0) qr[d0] = *(const bf16x8*)(Qw + d0 * 16 + hi * 8);
    unsigned selmask = 0u;
    if constexpr (MODE == 1) {
        f32x16 gacc = {};
        const int n = lane & 31;
#pragma unroll
        for (int d0 = 0; d0 < 4; ++d0) {
            bf16x8 a = {};
            if (n < 16) { const float* kp = D.ksum + (size_t)n * (6 * 64) + 16 * d0 + 8 * hi; const f32x4 x0 = *(const f32x4*)kp, x1 = *(const f32x4*)(kp + 4); a = __builtin_bit_cast(bf16x8, pack8(x0 * (1.0f / 256.0f), x1 * (1.0f / 256.0f))); }
            gacc = __builtin_amdgcn_mfma_f32_32x32x16_bf16(a, qr[d0], gacc, 0, 0, 0);
        }
        float cv[16]; int cn[16];
#pragma unroll
        for (int r = 0; r < 8; ++r) { cv[r] = gacc[r]; cn[r] = crow(r, hi); cv[8 + r] = __shfl_xor(gacc[r], 32); cn[8 + r] = crow(r, hi ^ 1); }
#pragma unroll
        for (int rep = 0; rep < 3; ++rep) {
            float best = NEG_INF; int bi = -1;
#pragma unroll
            for (int c = 0; c < 16; ++c) { const bool ok = cn[c] < D.qb && !((selmask >> cn[c]) & 1u); const bool better = ok && (bi < 0 || cv[c] > best || (cv[c] == best && cn[c] < bi)); if (better) { best = cv[c]; bi = cn[c]; } }
            if (bi >= 0) selmask |= 1u << bi;
        }
    }
    float mrun = NEG_INF, lrun = 0.f; f32x16 o[2]; o[0] = f32x16{}; o[1] = f32x16{};
    const int NT = D.nt;
    const LAS char* kp0 = (const LAS char*)shm + LDS_K + hi * 1024 + r32 * 16;
    const LAS char* vp0 = (const LAS char*)shm + LDS_V + ((lane >> 4) & 1) * 32 + (lane & 3) * 8 + (4 * hi + ((lane & 15) >> 2)) * 64;
    auto ktile = [&](int t) -> int { if constexpr (MODE == 1) return t < 4 ? (NT - 4 + t) : (t - 4); else return t; };
    auto dma = [&](int t, int slot) {
        const int kt = ktile(t);
        int krow = D.key0 + 64 * kt + lane; krow = krow < 0 ? 0 : krow;
        int vrow = D.key0 + 64 * kt + 16 * (wid & 3) + (lane >> 2); vrow = vrow < 0 ? 0 : vrow;
        glds16(D.k + (long)krow * D.kvs + wid * 8, (unsigned)__builtin_amdgcn_readfirstlane(lds0 + LDS_K + slot * SLOTB + wid * 1024));
        glds16(D.v + (long)vrow * D.kvs + (wid >> 2) * 32 + (lane & 3) * 8, (unsigned)__builtin_amdgcn_readfirstlane(lds0 + LDS_V + slot * SLOTB + wid * 1024));
    };
    dma(0, 0);
#pragma unroll 1
    for (int t = 0; t < NT; ++t) {
        asm volatile("s_waitcnt vmcnt(0) lgkmcnt(0)\n\ts_barrier" ::: "memory");
        if (t + 1 < NT) dma(t + 1, (t + 1) & 1);
        const int slot = t & 1, kt = ktile(t);
        bool relevant = true; bool lane_sel = true;
        if constexpr (MODE == 1) {
            if (t < 4) relevant = (64 * t) <= (32 * wid + 31);
            else { lane_sel = (selmask >> (kt >> 2)) & 1u; relevant = __any(lane_sel); }
        }
        if constexpr (MODE == 2) { const int q0 = 32 * wid; relevant = (64 * kt - 128 <= q0 + 31) && (64 * kt - 65 >= q0 - 128) && (D.key0 + 64 * kt + 63 >= 0); }
        if (relevant) {
            f32x16 p0 = {}, p1 = {};
            const LAS char* kb = kp0 + slot * SLOTB;
#pragma unroll
            for (int d0 = 0; d0 < 4; ++d0) {
                const bf16x8 b0 = *(const LAS bf16x8*)(kb + d0 * 2048), b1 = *(const LAS bf16x8*)(kb + d0 * 2048 + 512);
                p0 = __builtin_amdgcn_mfma_f32_32x32x16_bf16(b0, qr[d0], p0, 0, 0, 0); p1 = __builtin_amdgcn_mfma_f32_32x32x16_bf16(b1, qr[d0], p1, 0, 0, 0);
            }
            if constexpr (MODE == 1) {
                if (t < 4) { const int qrel = 32 * wid + r32, kb0 = 64 * t + 4 * hi;
#pragma unroll
                    for (int r = 0; r < 16; ++r) { const int kv = kb0 + (r & 3) + 8 * (r >> 2); if (kv > qrel) p0[r] = NEG_INF; if (kv + 32 > qrel) p1[r] = NEG_INF; } }
                else if (!lane_sel) {
#pragma unroll
                    for (int r = 0; r < 16; ++r) { p0[r] = NEG_INF; p1[r] = NEG_INF; } }
            }
            if constexpr (MODE == 2) {
                const int ql = D.qb + 32 * wid + r32, kl0 = D.key0 + 64 * kt + 4 * hi;
#pragma unroll
                for (int r = 0; r < 16; ++r) { const int kl = kl0 + (r & 3) + 8 * (r >> 2);
                    if (!(kl >= 0 && kl <= ql && ql - kl <= 128)) p0[r] = NEG_INF;
                    if (!(kl + 32 >= 0 && kl + 32 <= ql && ql - kl - 32 <= 128)) p1[r] = NEG_INF; }
            }
            const float rm = rowmax32(p0, p1);
            const float mnew = __builtin_fmaxf(mrun, rm);
            const float muse = (mnew == NEG_INF) ? 0.f : mnew;
            const float alpha = __builtin_amdgcn_exp2f(mrun - muse);
            float ps = 0.f;
#pragma unroll
            for (int r = 0; r < 16; ++r) { p0[r] = __builtin_amdgcn_exp2f(p0[r] - muse); p1[r] = __builtin_amdgcn_exp2f(p1[r] - muse); ps += p0[r] + p1[r]; }
            lrun = lrun * alpha + ps; mrun = mnew;
            if (__any(alpha != 1.0f)) {
                if (hi == 0) wsf[r32] = alpha;
                LDS_WAIT();
#pragma unroll
                for (int r = 0; r < 16; ++r) { const float f = wsf[crow(r, hi)]; o[0][r] *= f; o[1][r] *= f; }
            }
            u32x4 pw0, pw1, pw2, pw3;
            pw0 = (u32x4){cvtpk(p0[0], p0[1]), cvtpk(p0[2], p0[3]), cvtpk(p0[4], p0[5]), cvtpk(p0[6], p0[7])};
            pw1 = (u32x4){cvtpk(p0[8], p0[9]), cvtpk(p0[10], p0[11]), cvtpk(p0[12], p0[13]), cvtpk(p0[14], p0[15])};
            pw2 = (u32x4){cvtpk(p1[0], p1[1]), cvtpk(p1[2], p1[3]), cvtpk(p1[4], p1[5]), cvtpk(p1[6], p1[7])};
            pw3 = (u32x4){cvtpk(p1[8], p1[9]), cvtpk(p1[10], p1[11]), cvtpk(p1[12], p1[13]), cvtpk(p1[14], p1[15])};
            const LAS char* vb = vp0 + slot * SLOTB;
#pragma unroll
            for (int d0 = 0; d0 < 2; ++d0) {
                s16x4 lo[4], hh[4];
#pragma unroll
                for (int ks = 0; ks < 4; ++ks) { lo[ks] = vtr(vb + d0 * 4096 + ks * 1024); hh[ks] = vtr(vb + d0 * 4096 + ks * 1024 + 512); }
#define ATT_PK(k) (bf16x8){lo[k][0], lo[k][1], lo[k][2], lo[k][3], hh[k][0], hh[k][1], hh[k][2], hh[k][3]}
                o[d0] = __builtin_amdgcn_mfma_f32_32x32x16_bf16(__builtin_bit_cast(bf16x8, pw0), ATT_PK(0), o[d0], 0, 0, 0);
                o[d0] = __builtin_amdgcn_mfma_f32_32x32x16_bf16(__builtin_bit_cast(bf16x8, pw1), ATT_PK(1), o[d0], 0, 0, 0);
                o[d0] = __builtin_amdgcn_mfma_f32_32x32x16_bf16(__builtin_bit_cast(bf16x8, pw2), ATT_PK(2), o[d0], 0, 0, 0);
                o[d0] = __builtin_amdgcn_mfma_f32_32x32x16_bf16(__builtin_bit_cast(bf16x8, pw3), ATT_PK(3), o[d0], 0, 0, 0);
#undef ATT_PK
            }
        }
    }
    { auto rr = __builtin_amdgcn_permlane32_swap(__float_as_uint(lrun), __float_as_uint(lrun), false, false); lrun = __uint_as_float(rr[0]) + __uint_as_float(rr[1]); }
    if (hi == 0) wsf[32 + r32] = lrun;
    if (D.lse != nullptr && hi == 0) D.lse[(long)(wid * 32 + r32) * D.lses] = mrun + __builtin_amdgcn_logf(lrun);
    LDS_WAIT();
    bf16_t* Ow = D.o + (long)(wid * 32) * D.os;
    {
        LAS bf16_t* stg = (LAS bf16_t*)(shm + LDS_OST) + wid * 2048;
#pragma unroll
        for (int r = 0; r < 16; ++r) { const int orow = crow(r, hi); const float rli = __builtin_amdgcn_rcpf(wsf[32 + orow]);
#pragma unroll
            for (int d0 = 0; d0 < 2; ++d0) stg[orow * 64 + d0 * 32 + r32] = (bf16_t)(cvtpk(o[d0][r] * rli, 0.f) & 0xffffu); }
        LDS_WAIT();
#pragma unroll
        for (int i = 0; i < 4; ++i) { const int row = i * 8 + (lane >> 3), ch = lane & 7; const u32x4 v = *(const LAS u32x4*)(stg + row * 64 + ch * 8); *(u32x4*)(Ow + (long)row * D.os + ch * 8) = v; }
    }
    asm volatile("s_waitcnt lgkmcnt(0)\n\ts_barrier" ::: "memory");
}
}


#ifdef SELFCHECK
constexpr int CW_CHK = 600;
__device__ __forceinline__ float ldbf(const bf16_t* p) { return __uint_as_float((unsigned)(*p) << 16); }
__device__ __forceinline__ float bfr(float f) { return __uint_as_float(cvtpk(f, 0.f) << 16); }
__device__ __forceinline__ int chk_token(int s) { const unsigned h = (unsigned)s * 2654435761u; int t = (int)((h >> 7) % NTOK); if (s < 64) t = (s & 7) * SEQ + (s >> 3) * 37; if (s >= 64 && s < 128) t = (s & 7) * SEQ + SEQ - 1 - (s >> 3); return t; }
__device__ __forceinline__ void chk_report(unsigned* ctl, int idx, bool bad, int lane) { const bool anybad = __any(bad); if (lane == 0) { atomicAdd(ctl + CW_CHK + 16 + idx, 1u); if (anybad) atomicAdd(ctl + CW_CHK + idx, 1u); } }
__device__ __forceinline__ float wave_max(float v) {
#pragma unroll
    for (int o = 1; o < 64; o <<= 1) v = __builtin_fmaxf(v, __shfl_xor(v, o));
    return v;
}
__device__ __forceinline__ void rope_cs(int pos, int j, float& c, float& s) {
    const float f = j == 0 ? 1.0f : j == 1 ? 0.1939227432012558f : j == 2 ? 0.03760603070259094f : j == 3 ? 0.007292664609849453f : j == 4 ? 0.0014142135623842478f : j == 5 ? 0.00027424818836152554f : j == 6 ? 5.318296098266728e-05f : 1.0313386155758053e-05f;
    const double a = (double)pos * (double)f, rv = a * 0.15915494309189535, fr_ = rv - __builtin_rint(rv); const float ang = (float)(fr_ * 6.283185307179586); c = cosf(ang); s = sinf(ang);
}
__device__ __forceinline__ float naive_proj(const float* xrow, const float* W, int K, int N, int c) { float acc = 0.f; for (int k = 0; k < K; ++k) acc += bfr(xrow[k]) * bfr(W[(size_t)k * N + c]); return acc; }
struct ChkKeys { int mode, B0, B1, B2, own, pos, dil, lstep; long stride; };
__device__ __forceinline__ const bf16_t* chk_key(const ChkKeys& K, int i, int l, const bf16_t* base) {
    if (K.mode == 5) { const int g = i >> 2; const int bsel = g == 0 ? K.B0 : g == 1 ? K.B1 : g == 2 ? K.B2 : K.own; const int key = bsel * 256 + (i & 3) * 64 + l; const bool valid = bsel >= 0 && (g != 3 || key <= K.pos); return valid ? base + (size_t)key * K.stride : nullptr; }
    if (K.mode == 6) { const int j = l + 64 * i; const bool valid = j <= 128 && j <= K.lstep; return valid ? base + (size_t)(K.pos - j * K.dil) * K.stride : nullptr; }
    return base + (size_t)(l + 64 * i) * K.stride;
}
__device__ __forceinline__ float naive_att(const ChkKeys& K, int NS, float qv, const bf16_t* kbase, const bf16_t* vbase, LAS float* scs, int lane, float& lse2) {
    float mx = NEG_INF;
    for (int i = 0; i < NS; ++i) { const bf16_t* kp = chk_key(K, i, lane, kbase); const bool v = kp != nullptr; const bf16_t* kq = v ? kp : kbase; float acc = 0.f;
        for (int d = 0; d < 64; ++d) acc += __shfl(qv, d) * ldbf(kq + d);
        const float a = v ? acc : NEG_INF; scs[i * 64 + lane] = a; mx = __builtin_fmaxf(mx, a); }
    mx = wave_max(mx); float l = 0.f;
    for (int i = 0; i < NS; ++i) { const float p = __builtin_amdgcn_exp2f(scs[i * 64 + lane] - mx); scs[i * 64 + lane] = p; l += p; }
    l = wave_sum(l); LDS_WAIT();
    float oacc = 0.f;
    for (int i = 0; i < NS; ++i) for (int sl = 0; sl < 64; ++sl) { const bf16_t* vp = chk_key(K, i, sl, vbase); if (vp != nullptr) oacc += scs[i * 64 + sl] * ldbf(vp + lane); }
    LDS_WAIT();
    lse2 = mx + __builtin_amdgcn_logf(l); return oacc / l;
}
__device__ __forceinline__ void selfcheck_a(const Params& P, unsigned char* ws, unsigned* ctl, LAS float* scs, int gw, int NGW, int lane) {
    const bf16_t* qkv = (const bf16_t*)(ws + WS_QKV);
    for (int s = gw; s < 2048; s += NGW) {
        const int t = chk_token(s), b = t / SEQ, pos = t % SEQ;
        { const int head = s % 40, c = head * 64 + lane;
          float v = naive_proj(P.x + (size_t)t * DM, P.w_in, DM, WIN, c);
          const bool rope_head = head < 12 || (head >= 18 && head < 30);
          const float partner = __shfl_xor(v, 8);
          if (rope_head && lane < 16) { float cs, sn; rope_cs(P.positions[t], lane & 7, cs, sn); v = lane < 8 ? v * cs - partner * sn : v * cs + partner * sn; }
          const bool qhead = head < 6 || (head >= 18 && head < 24) || head >= 36; if (qhead) v *= C2;
          const float got = ldbf(qkv + (size_t)t * WIN + c);
          chk_report(ctl, 1, !(fabsf(got - v) <= 0.02f * fabsf(v) + 0.01f), lane); }
        { const int c = (s % 48) * 64 + lane; const float z = naive_proj(P.x + (size_t)t * DM, P.w_gate, DM, NGATE, c) + P.b_gate[c]; const float v = 1.f / (1.f + expf(-z));
          const float got = ldbf((const bf16_t*)(ws + WS_GATES) + (size_t)t * NGATE + c);
          chk_report(ctl, 2, !(fabsf(got - v) <= 0.01f), lane); }
        { const int blk = s % 16, h = (s / 16) % 6; float acc = 0.f; for (int r = 0; r < 256; ++r) acc += ldbf(qkv + ((size_t)b * SEQ + blk * 256 + r) * WIN + 1536 + h * 64 + lane);
          const float got = ((const float*)(ctl + CW_KSUM))[(((size_t)b * 16 + blk) * 6 + h) * 64 + lane];
          chk_report(ctl, 3, !(fabsf(got - acc) <= 0.02f * fabsf(acc) + 0.3f), lane); }
        { const int mr = (int)(((unsigned)s * 40503u) % 2048u), c = (s % 8) * 64 + lane; const float v = naive_proj(P.mem + (size_t)mr * DM, P.w_mem_kv, DM, 512, c);
          const float got = ldbf((const bf16_t*)(ws + WS_KVM) + (size_t)mr * 512 + c);
          chk_report(ctl, 4, !(fabsf(got - v) <= 0.02f * fabsf(v) + 0.01f), lane); }
        { const int h = s % 6, own = pos >> 8;
          const float qv = ldbf(qkv + (size_t)t * WIN + 1152 + h * 64 + lane);
          float gate = NEG_INF;
          { float acc = 0.f; const int n = lane & 15; const float* kp = (const float*)(ctl + CW_KSUM) + (((size_t)b * 16 + n) * 6 + h) * 64;
            for (int d = 0; d < 64; ++d) acc += __shfl(qv, d) * bfr(kp[d] * (1.0f / 256.0f)); if (lane < own && lane < 16) gate = acc; }
          ChkKeys K; K.mode = 5; K.B0 = -1; K.B1 = -1; K.B2 = -1; K.own = own; K.pos = pos; K.dil = 1; K.lstep = 0; K.stride = WIN;
          for (int rep = 0; rep < 3; ++rep) { float best = NEG_INF; int bi = -1;
              for (int n = 0; n < 16; ++n) { const float gn = __shfl(gate, n); const bool ok = n < own && n != K.B0 && n != K.B1 && n != K.B2; if (ok && (bi < 0 || gn > best)) { best = gn; bi = n; } }
              if (rep == 0) K.B0 = bi; else if (rep == 1) K.B1 = bi; else K.B2 = bi; }
          float l2; const float want = naive_att(K, 16, qv, qkv + (size_t)b * SEQ * WIN + 1536 + h * 64, qkv + (size_t)b * SEQ * WIN + 1920 + h * 64, scs, lane, l2);
          const float got = ldbf((const bf16_t*)(ws + WS_YMOBA) + (size_t)t * 384 + h * 64 + lane);
          const float scale = wave_max(fabsf(want));
          chk_report(ctl, 5, !(fabsf(got - want) <= 0.03f * scale + 2e-3f), lane); }
        { const int hg = s & 1; float lg0 = 0.f, lg1 = 0.f, lg2 = 0.f, og0 = 0.f, og1 = 0.f, og2 = 0.f;
          for (int g = 0; g < 3; ++g) { const int hd = 2 * g + hg, dil = g == 0 ? 1 : g == 1 ? 4 : 16;
              ChkKeys K; K.mode = 6; K.B0 = K.B1 = K.B2 = -1; K.own = 0; K.pos = pos; K.dil = dil; K.lstep = pos / dil; K.stride = WIN;
              const float qv = ldbf(qkv + (size_t)t * WIN + hd * 64 + lane); float l2;
              const float o = naive_att(K, 3, qv, qkv + (size_t)b * SEQ * WIN + 384 + hd * 64, qkv + (size_t)b * SEQ * WIN + 768 + hd * 64, scs, lane, l2);
              if (g == 0) { og0 = o; lg0 = l2; } else if (g == 1) { og1 = o; lg1 = l2; } else { og2 = o; lg2 = l2; } }
          const float mm = __builtin_fmaxf(lg0, __builtin_fmaxf(lg1, lg2)); const float e0 = exp2f(lg0 - mm), e1 = exp2f(lg1 - mm), e2 = exp2f(lg2 - mm);
          const float want = (e0 * og0 + e1 * og1 + e2 * og2) / (e0 + e1 + e2);
          const float got = ldbf((const bf16_t*)(ws + WS_YDIL) + (size_t)t * 128 + hg * 64 + lane); const float scale = wave_max(fabsf(want));
          chk_report(ctl, 6, !(fabsf(got - want) <= 0.03f * scale + 2e-3f), lane); }
        { const int h = s & 3; const float qv = ldbf(qkv + (size_t)t * WIN + 2304 + h * 64 + lane);
          const bf16_t* kbase = (const bf16_t*)(ws + WS_KVM) + (size_t)b * 256 * 512 + h * 64;
          ChkKeys K; K.mode = 7; K.B0 = K.B1 = K.B2 = -1; K.own = 0; K.pos = 0; K.dil = 1; K.lstep = 0; K.stride = 512; float l2;
          const float want = naive_att(K, 4, qv, kbase, kbase + 256, scs, lane, l2);
          const float got = ldbf((const bf16_t*)(ws + WS_YMEM) + (size_t)t * 256 + h * 64 + lane); const float scale = wave_max(fabsf(want));
          chk_report(ctl, 7, !(fabsf(got - want) <= 0.03f * scale + 2e-3f), lane); }
    }
}
__device__ __forceinline__ void selfcheck_b(const Params& P, unsigned char* ws, unsigned* ctl, int gw, int NGW, int lane) {
    for (int s = gw; s < 2048; s += NGW) {
        const int t = chk_token(s);
        { const int c = (s % 16) * 64 + lane; const bf16_t* gates = (const bf16_t*)(ws + WS_GATES) + (size_t)t * NGATE;
          float p0 = 0.f, p1 = 0.f, p2 = 0.f;
          for (int k = 0; k < 128; ++k) p0 += ldbf((const bf16_t*)(ws + WS_YDIL) + (size_t)t * 128 + k) * bfr(P.w_br_dil[(size_t)k * DM + c]);
          for (int k = 0; k < 384; ++k) p1 += ldbf((const bf16_t*)(ws + WS_YMOBA) + (size_t)t * 384 + k) * bfr(P.w_br_moba[(size_t)k * DM + c]);
          for (int k = 0; k < 256; ++k) p2 += ldbf((const bf16_t*)(ws + WS_YMEM) + (size_t)t * 256 + k) * bfr(P.w_br_mem[(size_t)k * DM + c]);
          const float want = ldbf(gates + c) * p0 + ldbf(gates + 1024 + c) * p1 + ldbf(gates + 2048 + c) * p2, got = ldbf((const bf16_t*)(ws + WS_MERGED) + (size_t)t * DM + c);
          const float scale = wave_max(fabsf(want));
          chk_report(ctl, 8, !(fabsf(got - want) <= 0.03f * scale + 1e-3f), lane); }
        { const int c = (s % 16) * 64 + lane; float acc = 0.f; for (int k = 0; k < DM; ++k) acc += ldbf((const bf16_t*)(ws + WS_MERGED) + (size_t)t * DM + k) * bfr(P.w_out[(size_t)k * DM + c]);
          const float want = ALPHA * P.x[(size_t)t * DM + c] + acc, got = ((const float*)(ws + WS_X1F))[(size_t)t * DM + c];
          const float scale = wave_max(fabsf(acc));
          chk_report(ctl, 9, !(fabsf(got - want) <= 0.02f * scale + 1e-4f), lane); }
    }
}
#endif

#define XB_TMO      128
#define XB_XCNT(j)  (256  + 64 * (j))
#define XB_XSUB(j)  (1280 + 64 * (j))
#define XB_XGEN(j)  (2304 + 64 * (j))
#define XB_TOP      3328
#define XB_TOPGEN   3392
#define XCD_BAR_WORDS 3456
#define XB_SPIN_CAP (1u << 18)
__device__ __forceinline__ unsigned xb_ld(unsigned* p)              { return __hip_atomic_load(p, __ATOMIC_RELAXED, __HIP_MEMORY_SCOPE_AGENT); }
__device__ __forceinline__ unsigned xb_add(unsigned* p, unsigned v) { return __hip_atomic_fetch_add(p, v, __ATOMIC_RELAXED, __HIP_MEMORY_SCOPE_AGENT); }
__device__ __forceinline__ unsigned xb_xcc_id() { return (unsigned)__builtin_amdgcn_s_getreg((3 << 11) | 20) & 0xFu; }
#define XB_SPIN(cond, bar) do { unsigned _sp = 0; while (cond) { __builtin_amdgcn_s_sleep(1); \
    if ((++_sp & 255u) == 0u) { if (xb_ld(&(bar)[XB_TMO])) break; if (_sp > XB_SPIN_CAP) { atomicAdd(&(bar)[XB_TMO], 1u); break; } } } } while (0)
struct XcdBarrier { unsigned* bar; unsigned x; volatile LAS unsigned* st; };
__device__ __forceinline__ XcdBarrier xcd_barrier_post(unsigned* bar, volatile LAS unsigned* st) {
    XcdBarrier b; b.bar = bar; b.x = xb_xcc_id(); b.st = st;
    if (threadIdx.x == 0) (void)xb_add(&bar[XB_XCNT(b.x)], 1u);
    return b;
}
__device__ __forceinline__ void xcd_barrier_complete(unsigned* bar, unsigned x, unsigned& nloc, unsigned& nx) {
    const unsigned G = gridDim.x * gridDim.y * gridDim.z;
    unsigned sum, cnt, mine, sp = 0u;
    for (;;) {
        sum = 0u; cnt = 0u; mine = 0u;
#pragma unroll
        for (unsigned j = 0; j < 16; ++j) { const unsigned c = xb_ld(&bar[XB_XCNT(j)]); sum += c; cnt += (c > 0u) ? 1u : 0u; mine = (j == x) ? c : mine; }
        if (sum == G) break;
        __builtin_amdgcn_s_sleep(1);
        if ((++sp & 255u) == 0u) { if (xb_ld(&bar[XB_TMO])) break; if (sp > XB_SPIN_CAP) { atomicAdd(&bar[XB_TMO], 1u); break; } }
    }
    nloc = mine > 0u ? mine : 1u; nx = cnt > 0u ? cnt : 1u;
}
__device__ __forceinline__ void xcd_barrier(const XcdBarrier& b) {
    asm volatile("s_waitcnt vmcnt(0)" ::: "memory");
    __syncthreads();
    if (threadIdx.x == 0) {
        unsigned* bar = b.bar;
        __builtin_amdgcn_s_waitcnt(0);
        unsigned nloc = b.st[0], nx = b.st[1];
        if (nloc == 0u) { xcd_barrier_complete(bar, b.x, nloc, nx); b.st[0] = nloc; b.st[1] = nx; }
        const unsigned old = xb_add(&bar[XB_XSUB(b.x)], 1u);
        const unsigned gen = old / nloc;
        if (old + 1u == (gen + 1u) * nloc) {
            __builtin_amdgcn_fence(__ATOMIC_RELEASE, "agent");
            asm volatile("s_waitcnt vmcnt(0)" ::: "memory");
            const unsigned og = xb_add(&bar[XB_TOP], 1u);
            const unsigned tg = og / nx;
            if (og + 1u == (tg + 1u) * nx) xb_add(&bar[XB_TOPGEN], 1u);
            else XB_SPIN(xb_ld(&bar[XB_TOPGEN]) == tg, bar);
            __builtin_amdgcn_fence(__ATOMIC_ACQUIRE, "agent");
            xb_add(&bar[XB_XGEN(b.x)], 1u);
            asm volatile("s_waitcnt vmcnt(0)" ::: "memory");
        } else {
            XB_SPIN(xb_ld(&bar[XB_XGEN(b.x)]) == gen, bar);
            __builtin_amdgcn_fence(__ATOMIC_ACQUIRE, "agent");
            asm volatile("s_waitcnt vmcnt(0)" ::: "memory");
        }
    }
    __syncthreads();
}
constexpr int NWAVES = 8, NTHREADS = NWAVES * 64;
constexpr int RING_BYTES = 131072, MISC_OFF = RING_BYTES, LDS_BYTES = 147456;

#ifndef PHASE_MASK
#define PHASE_MASK 0xFFFF
#endif
#define PH(k) (((PHASE_MASK) >> (k)) & 1)
#ifndef REPEAT_MASK
#define REPEAT_MASK 0
#endif
#define NREP(k) ((((REPEAT_MASK) >> (k)) & 1) ? 2 : 1)
#ifndef ATT_MASK
#define ATT_MASK 7
#endif
#define ATT_EN(k) (((ATT_MASK) >> (k)) & 1)
__global__ void __launch_bounds__(NTHREADS, 2) fwd_megakernel(Params P) {
    extern __shared__ __attribute__((aligned(16))) unsigned char lds_raw[];
    cg::grid_group grid = cg::this_grid();
    LAS unsigned char* lds = (LAS unsigned char*)lds_raw;
    unsigned char* ws = P.ws;
    const int tid = threadIdx.x, lane = tid & 63, wave = __builtin_amdgcn_readfirstlane(tid >> 6);
    const int G = gridDim.x, bx = blockIdx.x;
    const int gw = bx * NWAVES + wave, NGW = G * NWAVES, gtid = bx * NTHREADS + tid, NTHR = G * NTHREADS;
    unsigned* ctl = (unsigned*)(ws + WS_CTL);

    if (tid < 4) ((LAS unsigned*)(lds + MISC_OFF + 16))[tid] = 0u;
    if constexpr (PH(0)) for (int rep_ = 0; rep_ < NREP(0); ++rep_) p0_prologue(P, lds, gw, NGW, gtid, NTHR, lane, wave);
    grid.sync();
    const XcdBarrier xbar = xcd_barrier_post(ctl + CW_BAR, (volatile LAS unsigned*)(lds + MISC_OFF + 16));
#define GRID_BAR() xcd_barrier(xbar)

    if constexpr (PH(1)) {
        LaneGeom geom; { int t_ = threadIdx.x; asm volatile("" : "+v"(t_)); geom.init(t_); }
        SchedP1 S{geom, G, bx, ws};
        EpiP1 E{(bf16_t*)(ws + WS_QKV), (bf16_t*)(ws + WS_GATES), (bf16_t*)(ws + WS_KVM), P.b_gate, (const float*)(ws + WS_ROPE), (float*)(ctl + CW_KSUM)};
        pg8::gemm_phase<EpiP1, SchedP1, true>(lds, S, E); if constexpr (NREP(1) == 2) { pg8::gemm_phase<EpiP1, SchedP1, true>(lds, S, E); }
    }
    GRID_BAR();

    if constexpr (PH(2)) {
        LAS int* qslot = (LAS int*)(lds + MISC_OFF);
        const bf16_t* qkv = (const bf16_t*)(ws + WS_QKV);
        for (int rep_ = 0; rep_ < NREP(2); ++rep_) {
#define ATT_POP(base, count) int idx; { if (tid == 0) qslot[0] = (int)atomicAdd(ctl + CW_QUEUE + 4 * rep_ + (base), 1u); __syncthreads(); idx = __builtin_amdgcn_readfirstlane(qslot[0]); __syncthreads(); } if (idx >= (count)) break;
        if (ATT_EN(1)) for (;;) {
            ATT_POP(0, 768)
            att::Desc D;
            const int qb = 15 - idx / 48, bh = idx % 48, b = bh / 6, h = bh % 6;
            const size_t tok0 = (size_t)b * SEQ;
            D.q = qkv + (tok0 + 256 * qb) * WIN + 1152 + h * 64; D.qs = WIN;
            D.k = qkv + tok0 * WIN + 1536 + h * 64; D.v = qkv + tok0 * WIN + 1920 + h * 64; D.kvs = WIN; D.key0 = 0;
            D.o = (bf16_t*)(ws + WS_YMOBA) + (tok0 + 256 * qb) * 384 + h * 64; D.os = 384; D.lse = nullptr; D.lses = 0;
            D.nt = 4 * qb + 4; D.mode = 1; D.qb = qb; D.ksum = (const float*)(ctl + CW_KSUM) + ((size_t)b * 16 * 6 + h) * 64;
            att::attn_unit<1>((LAS char*)lds, D);
        }
        if (ATT_EN(2)) for (;;) {
            ATT_POP(1, 768)
            att::Desc D;
            const int bh = idx >> 4, sub = idx & 15, b = bh / 6, hd = bh % 6, gI = hd >> 1;
            const int dil = gI == 0 ? 1 : (gI == 1 ? 4 : 16);
            const int res = gI == 0 ? 0 : (gI == 1 ? (sub & 3) : sub), ub = gI == 0 ? sub : (gI == 1 ? (sub >> 2) : 0);
            const size_t tok0 = (size_t)b * SEQ + res;
            D.q = qkv + (tok0 + (size_t)256 * ub * dil) * WIN + hd * 64; D.qs = (long)dil * WIN;
            D.k = qkv + tok0 * WIN + 384 + hd * 64; D.v = qkv + tok0 * WIN + 768 + hd * 64; D.kvs = (long)dil * WIN; D.key0 = 256 * ub - 128;
            D.o = (bf16_t*)(ws + WS_ODIL) + (tok0 + (size_t)256 * ub * dil) * 384 + hd * 64; D.os = (long)dil * 384;
            D.lse = (float*)(ws + WS_LSE) + (tok0 + (size_t)256 * ub * dil) * 6 + hd; D.lses = (long)dil * 6;
            D.nt = 6; D.mode = 2; D.qb = 256 * ub; D.ksum = nullptr;
            att::attn_unit<2>((LAS char*)lds, D);
        }
        if (ATT_EN(0)) for (;;) {
            ATT_POP(2, 512)
            att::Desc D;
            const int b = idx >> 6, h = (idx >> 4) & 3, qblk = idx & 15;
            const size_t tok0 = (size_t)b * SEQ + 256 * qblk;
            const bf16_t* kvm = (const bf16_t*)(ws + WS_KVM) + (size_t)b * 256 * 512;
            D.q = qkv + tok0 * WIN + 2304 + h * 64; D.qs = WIN;
            D.k = kvm + h * 64; D.v = kvm + 256 + h * 64; D.kvs = 512; D.key0 = 0;
            D.o = (bf16_t*)(ws + WS_YMEM) + tok0 * 256 + h * 64; D.os = 256; D.lse = nullptr; D.lses = 0;
            D.nt = 4; D.mode = 0; D.qb = 0; D.ksum = nullptr;
            att::attn_unit<0>((LAS char*)lds, D);
        }
        }
#undef ATT_POP
    }
    GRID_BAR();

    if constexpr (PH(3)) {
        const bf16_t* odil = (const bf16_t*)(ws + WS_ODIL); const float* lse = (const float*)(ws + WS_LSE); bf16_t* ydil = (bf16_t*)(ws + WS_YDIL);
        for (int tkn = gw; tkn < NTOK; tkn += NGW) {
            const int hg = lane >> 5, dd = (lane & 31) * 2;
            const float l0 = lse[(size_t)tkn * 6 + hg], l1 = lse[(size_t)tkn * 6 + 2 + hg], l2 = lse[(size_t)tkn * 6 + 4 + hg];
            const float mx = __builtin_fmaxf(l0, __builtin_fmaxf(l1, l2));
            const float e0 = __builtin_amdgcn_exp2f(l0 - mx), e1 = __builtin_amdgcn_exp2f(l1 - mx), e2 = __builtin_amdgcn_exp2f(l2 - mx), inv = 1.0f / (e0 + e1 + e2);
            const unsigned a0 = *(const unsigned*)(odil + (size_t)tkn * 384 + hg * 64 + dd), a1 = *(const unsigned*)(odil + (size_t)tkn * 384 + 128 + hg * 64 + dd), a2 = *(const unsigned*)(odil + (size_t)tkn * 384 + 256 + hg * 64 + dd);
            const float y0 = (e0 * bflo(a0) + e1 * bflo(a1) + e2 * bflo(a2)) * inv, y1 = (e0 * bfhi(a0) + e1 * bfhi(a1) + e2 * bfhi(a2)) * inv;
            *(unsigned*)(ydil + (size_t)tkn * 128 + hg * 64 + dd) = cvtpk(y0, y1);
        }
    }
    GRID_BAR();

#ifdef SELFCHECK
    selfcheck_a(P, ws, ctl, (LAS float*)(lds + wave * 16384), gw, NGW, lane);
    grid.sync();
#endif
    if constexpr (PH(4)) {
        LaneGeom geom; { int t_ = threadIdx.x; asm volatile("" : "+v"(t_)); geom.init(t_); }
        SchedP3 S{geom, G, bx, ws};
        EpiP3 E{(const bf16_t*)(ws + WS_GATES), (bf16_t*)(ws + WS_MERGED)};
        pg8::gemm_phase<EpiP3, SchedP3, true>(lds, S, E); if constexpr (NREP(4) == 2) { pg8::gemm_phase<EpiP3, SchedP3, true>(lds, S, E); }
    }
    GRID_BAR();

    if constexpr (PH(5)) {
        LaneGeom geom; { int t_ = threadIdx.x; asm volatile("" : "+v"(t_)); geom.init(t_); }
        SchedP4 S{geom, G, bx, ws};
        EpiP4 E{P.x, (float*)(ws + WS_X1F)};
        pg8::gemm_phase<EpiP4, SchedP4, true>(lds, S, E); if constexpr (NREP(5) == 2) { pg8::gemm_phase<EpiP4, SchedP4, true>(lds, S, E); }
    }
    GRID_BAR();

#ifdef SELFCHECK
    selfcheck_b(P, ws, ctl, gw, NGW, lane);
    grid.sync();
#endif
    if constexpr (PH(6)) {
        for (int rep_ = 0; rep_ < NREP(6); ++rep_) {
        float* x1f = (float*)(ws + WS_X1F); bf16_t* x1b = rep_ == 0 ? (bf16_t*)(ws + WS_X1B) : (bf16_t*)(ws + WS_QKV); float* x1o = rep_ == 0 ? x1f : (float*)(ws + WS_GATES);
        for (int row = gw; row < NTOK; row += NGW) {
            f32x4* xr = (f32x4*)(x1f + (size_t)row * DM) + lane; f32x4* xo = (f32x4*)(x1o + (size_t)row * DM) + lane;
            f32x4 v[4]; float s = 0.f;
#pragma unroll
            for (int j = 0; j < 4; ++j) { v[j] = xr[64 * j]; s += (v[j][0] + v[j][1]) + (v[j][2] + v[j][3]); }
            const float mean = wave_sum(s) * (1.f / DM); float s2 = 0.f;
#pragma unroll
            for (int j = 0; j < 4; ++j) { v[j] = v[j] - mean; s2 += (v[j][0] * v[j][0] + v[j][1] * v[j][1]) + (v[j][2] * v[j][2] + v[j][3] * v[j][3]); }
            const float rstd = __builtin_amdgcn_rsqf(wave_sum(s2) * (1.f / DM) + LN_EPS);
#pragma unroll
            for (int j = 0; j < 4; ++j) {
                const f32x4 gg = *((const f32x4*)P.ln1_g + lane + 64 * j), bb = *((const f32x4*)P.ln1_b + lane + 64 * j);
                const f32x4 y = v[j] * rstd * gg + bb;
                xo[64 * j] = y;
                u32x2 w; w.x = cvtpk(y[0], y[1]); w.y = cvtpk(y[2], y[3]);
                *((u32x2*)(x1b + (size_t)row * DM) + lane + 64 * j) = w;
            }
        }
        }
    }
    GRID_BAR();

    if constexpr (PH(7)) {
        LaneGeom geom; { int t_ = threadIdx.x; asm volatile("" : "+v"(t_)); geom.init(t_); }
        SchedP6 S{geom, G, bx, ws};
        EpiP6 E{(float*)(ws + WS_SCORES), (bf16_t*)(ws + WS_HIDS)};
        pg8::gemm_phase<EpiP6, SchedP6, true>(lds, S, E); if constexpr (NREP(7) == 2) { pg8::gemm_phase<EpiP6, SchedP6, true>(lds, S, E); }
    }
    GRID_BAR();

    if constexpr (PH(8)) {
        const float* scores = (const float*)(ws + WS_SCORES);
        int* eidx = (int*)(ws + WS_EIDX); float* gwt = (float*)(ws + WS_GWT); int* pos = (int*)(ws + WS_POS);
        const int j = lane & 7, lbase = lane & 56;
        f32x4 rb[8];
#pragma unroll
        for (int q = 0; q < 8; ++q) rb[q] = *((const f32x4*)(P.router_bias + 32 * j) + q);
        for (int t0 = gw * 8; t0 < NTOK; t0 += NGW * 8) {
            const int tkn = t0 + (lane >> 3);
            f32x4 sc[8];
#pragma unroll
            for (int q = 0; q < 8; ++q) sc[q] = *((const f32x4*)(scores + (size_t)tkn * 256 + 32 * j) + q);
            float m1 = NEG_INF, m2 = NEG_INF;
#pragma unroll
            for (int q = 0; q < 8; ++q)
#pragma unroll
                for (int e = 0; e < 4; ++e) { const float v = sc[q][e] + rb[q][e]; m2 = __builtin_fmaxf(m2, __builtin_fminf(m1, v)); m1 = __builtin_fmaxf(m1, v); }
            const float gs = m1 + m2; int rank = 0;
#pragma unroll
            for (int jj = 0; jj < 8; ++jj) { const float og = __shfl(gs, lbase + jj); rank += (og > gs || (og == gs && jj < j)) ? 1 : 0; }
            unsigned removed = rank < 4 ? 0u : 0xffffffffu;
            int my_e = 0; float my_s = 0.f;
#pragma unroll 1
            for (int k = 0; k < TOPK; ++k) {
                float bv = NEG_INF, bs = 0.f; int bi = 32 * j;
#pragma unroll
                for (int q = 0; q < 8; ++q)
#pragma unroll
                    for (int e = 0; e < 4; ++e) { const int i = 4 * q + e; const float v = ((removed >> i) & 1u) ? NEG_INF : sc[q][e] + rb[q][e]; if (v > bv) { bv = v; bs = sc[q][e]; bi = 32 * j + i; } }
#pragma unroll
                for (int o = 1; o < 8; o <<= 1) { const float ov = __shfl_xor(bv, o), os = __shfl_xor(bs, o); const int oi = __shfl_xor(bi, o); if (ov > bv || (ov == bv && oi < bi)) { bv = ov; bs = os; bi = oi; } }
                if (j == k) { my_e = bi; my_s = bs; }
                if ((bi >> 5) == j) removed |= 1u << (bi & 31);
            }
            float ssum = my_s;
#pragma unroll
            for (int o = 1; o < 8; o <<= 1) ssum += __shfl_xor(ssum, o);
            const unsigned r = atomicAdd(ctl + CW_COUNT + my_e, 1u);
            eidx[(size_t)tkn * 8 + j] = my_e; gwt[(size_t)tkn * 8 + j] = my_s / ssum * 2.5f; pos[(size_t)tkn * 8 + j] = (int)r;
        }
    }
    GRID_BAR();

    if constexpr (PH(9)) {
        LAS int* pad_start = (LAS int*)(lds + MISC_OFF + 64);
        LAS int* cstart = pad_start + 260;
        LAS int* cnt_s = cstart + 260;
        if (wave == 0) {
            int c4[4], p4[4]; int csum = 0, psum = 0;
#pragma unroll
            for (int i = 0; i < 4; ++i) { c4[i] = (int)ctl[CW_COUNT + 4 * lane + i]; p4[i] = (c4[i] + 255) & ~255; csum += c4[i]; psum += p4[i]; }
            int cin = csum, pin = psum;
#pragma unroll
            for (int o = 1; o < 64; o <<= 1) { const int a = __shfl_up(cin, o), b = __shfl_up(pin, o); if (lane >= o) { cin += a; pin += b; } }
            int ce = cin - csum, pe = pin - psum;
#pragma unroll
            for (int i = 0; i < 4; ++i) { cstart[4 * lane + i] = ce; pad_start[4 * lane + i] = pe; cnt_s[4 * lane + i] = c4[i]; ce += c4[i]; pe += p4[i]; }
            if (lane == 63) { cstart[256] = ce; pad_start[256] = pe; }
        }
        __syncthreads();
        if (bx == 0) {
            if (tid < 256) { const int t0 = pad_start[tid] >> 8, t1 = pad_start[tid + 1] >> 8; for (int t = t0; t < t1; ++t) ctl[CW_TILEE + t] = (unsigned)tid; }
            if (tid == 0) ctl[CW_RT] = (unsigned)(pad_start[256] >> 8);
        }
        const int* eidx = (const int*)(ws + WS_EIDX); const float* gwt = (const float*)(ws + WS_GWT); int* pos = (int*)(ws + WS_POS);
        int* row_tok = (int*)(ws + WS_ROWTOK); float* row_w = (float*)(ws + WS_ROWW); int* row_y = (int*)(ws + WS_ROWY);
        for (int a = gtid; a < NASSIGN; a += NTHR) {
            const int e = eidx[a], r = pos[a]; const int d = pad_start[e] + r, cc = cstart[e] + r;
            row_tok[d] = a >> 3; row_w[d] = gwt[a]; row_y[d] = cc; pos[a] = cc;
        }
        for (int i = gtid; i < NEXP * 256; i += NTHR) {
            const int e = i >> 8, jj = cnt_s[e] + (i & 255);
            if (jj < pad_start[e + 1] - pad_start[e]) { const int d = pad_start[e] + jj; row_tok[d] = 0; row_w[d] = 0.f; row_y[d] = -1; }
        }
    }
    GRID_BAR();

    const int RT = (int)__builtin_amdgcn_readfirstlane(((volatile unsigned*)ctl)[CW_RT]);
    if constexpr (PH(10)) {
        LaneGeom geom; { int t_ = threadIdx.x; asm volatile("" : "+v"(t_)); geom.init(t_); }
        SchedP9 S{geom, G, bx, ws, 2 * RT};
        EpiP9 E{(bf16_t*)(ws + WS_HID)};
        pg8::gemm_phase<EpiP9, SchedP9, true>(lds, S, E); if constexpr (NREP(10) == 2) { pg8::gemm_phase<EpiP9, SchedP9, true>(lds, S, E); }
    }
    GRID_BAR();

    if constexpr (PH(11)) {
        LaneGeom geom; { int t_ = threadIdx.x; asm volatile("" : "+v"(t_)); geom.init(t_); }
        SchedP10 S{geom, G, bx, ws, 4 * RT};
        EpiP10 E{ws, (const int*)(ws + WS_ROWY), (const float*)(ws + WS_ROWW)};
        pg8::gemm_phase<EpiP10, SchedP10, true>(lds, S, E); if constexpr (NREP(11) == 2) { pg8::gemm_phase<EpiP10, SchedP10, true>(lds, S, E); }
        SchedP10s S2{geom, G, bx, ws, (4 * RT) % G};
        if constexpr (NREP(13) == 2) { EpiP10s E3{(float*)(ws + WS_X1F), (float*)(ws + WS_XB)}; pg8::gemm_phase<EpiP10s, SchedP10s, true>(lds, S2, E3); }
        EpiP10s E2{(float*)(ws + WS_X1F), (float*)(ws + WS_X1F)};
        pg8::gemm_phase<EpiP10s, SchedP10s, true>(lds, S2, E2);
    }
    GRID_BAR();

    if constexpr (PH(12)) {
        const float* x1f = (const float*)(ws + WS_X1F); const int* pos = (const int*)(ws + WS_POS);
        for (int rep_ = 0; rep_ < NREP(12); ++rep_)
        for (int row = gw; row < NTOK; row += NGW) {
            const f32x4* xr = (const f32x4*)(x1f + (size_t)row * DM) + lane;
            f32x4 v[4];
#pragma unroll
            for (int j = 0; j < 4; ++j) v[j] = xr[64 * j];
#pragma unroll
            for (int k = 0; k < TOPK; ++k) {
                const int yr = __builtin_amdgcn_readfirstlane(pos[(size_t)row * 8 + k]);
                const u32x2* yp = (const u32x2*)y_row(ws, yr) + lane;
#pragma unroll
                for (int j = 0; j < 4; ++j) { const u32x2 w = yp[64 * j]; v[j][0] += bflo(w.x); v[j][1] += bfhi(w.x); v[j][2] += bflo(w.y); v[j][3] += bfhi(w.y); }
            }
            float s = 0.f;
#pragma unroll
            for (int j = 0; j < 4; ++j) s += (v[j][0] + v[j][1]) + (v[j][2] + v[j][3]);
            const float mean = wave_sum(s) * (1.f / DM); float s2 = 0.f;
#pragma unroll
            for (int j = 0; j < 4; ++j) { v[j] = v[j] - mean; s2 += (v[j][0] * v[j][0] + v[j][1] * v[j][1]) + (v[j][2] * v[j][2] + v[j][3] * v[j][3]); }
            const float rstd = __builtin_amdgcn_rsqf(wave_sum(s2) * (1.f / DM) + LN_EPS);
            f32x4* orow = (f32x4*)(P.out + (size_t)row * DM) + lane;
#pragma unroll
            for (int j = 0; j < 4; ++j) { const f32x4 gg = *((const f32x4*)P.ln2_g + lane + 64 * j), bb = *((const f32x4*)P.ln2_b + lane + 64 * j); orow[64 * j] = v[j] * rstd * gg + bb; }
        }
#ifdef SELFCHECK
        if (gw == 0 && lane == 0) {
            VM_WAIT();
            int first = 0; float frac = 0.f;
            for (int i = 1; i < 10; ++i) { const unsigned bad = ((volatile unsigned*)ctl)[CW_CHK + i], tot = ((volatile unsigned*)ctl)[CW_CHK + 16 + i]; if (first == 0 && (bad > 0u || tot != 2048u)) { first = i; frac = tot == 2048u ? (float)bad / 2048.f : 1.f; } }
            if (first > 0) P.out[0] = sqrtf(33554432.f * (3.f * (float)first + 2.f * frac));
        }
#endif
    }
}

extern "C" void kernel_launch(void* const* d_in, const int* in_sizes, int n_in, void* d_out, int out_size, void* d_ws, size_t ws_size, hipStream_t stream) {
    static int grid = 0;
    if (grid == 0) {
        if (n_in != 23 || out_size != NTOK * DM || ws_size < WS_END) { fprintf(stderr, "kernel_launch: unexpected shapes (n_in %d, out %d, ws %zu)\n", n_in, out_size, ws_size); grid = -1; return; }
        int dev = 0, cus = 0, per_cu = 0;
        if (hipGetDevice(&dev) != hipSuccess || hipDeviceGetAttribute(&cus, hipDeviceAttributeMultiprocessorCount, dev) != hipSuccess) { grid = -1; return; }
        if (hipFuncSetAttribute((const void*)fwd_megakernel, hipFuncAttributeMaxDynamicSharedMemorySize, LDS_BYTES) != hipSuccess) { fprintf(stderr, "kernel_launch: hipFuncSetAttribute failed\n"); grid = -1; return; }
        if (hipOccupancyMaxActiveBlocksPerMultiprocessor(&per_cu, (const void*)fwd_megakernel, NTHREADS, LDS_BYTES) != hipSuccess || per_cu < 1) { fprintf(stderr, "kernel_launch: occupancy query failed (%d)\n", per_cu); grid = -1; return; }
        grid = cus * 1;
    }
    if (grid < 0) return;
    Params p{};
    p.x = (const float*)d_in[0]; p.mem = (const float*)d_in[1]; p.positions = (const int*)d_in[2];
    p.w_in = (const float*)d_in[3]; p.w_mem_kv = (const float*)d_in[4]; p.w_gate = (const float*)d_in[5]; p.b_gate = (const float*)d_in[6];
    p.w_br_dil = (const float*)d_in[7]; p.w_br_moba = (const float*)d_in[8]; p.w_br_mem = (const float*)d_in[9]; p.w_out = (const float*)d_in[10];
    p.ln1_g = (const float*)d_in[11]; p.ln1_b = (const float*)d_in[12]; p.w_router = (const float*)d_in[13]; p.router_bias = (const float*)d_in[14];
    p.w_e_gate = (const float*)d_in[15]; p.w_e_up = (const float*)d_in[16]; p.w_e_down = (const float*)d_in[17];
    p.w_s_gate = (const float*)d_in[18]; p.w_s_up = (const float*)d_in[19]; p.w_s_down = (const float*)d_in[20]; p.ln2_g = (const float*)d_in[21]; p.ln2_b = (const float*)d_in[22];
    p.out = (float*)d_out; p.ws = (unsigned char*)d_ws;
    void* args[] = {&p};
    hipError_t e = hipLaunchCooperativeKernel((const void*)fwd_megakernel, dim3(grid), dim3(NTHREADS), args, LDS_BYTES, stream);
    if (e != hipSuccess) fprintf(stderr, "kernel_launch: cooperative launch failed: %s (grid %d)\n", hipGetErrorString(e), grid);
}
```

```cpp
#include <hip/hip_runtime.h>
#include <hip/hip_cooperative_groups.h>
#include <cstdint>
#include <cstdio>
namespace cg = cooperative_groups;

#define LAS __attribute__((address_space(3)))
typedef unsigned short bf16_t;
typedef short bf16x8 __attribute__((ext_vector_type(8)));
typedef short s16x4 __attribute__((ext_vector_type(4)));
typedef float f32x2 __attribute__((ext_vector_type(2)));
typedef float f32x4 __attribute__((ext_vector_type(4)));
typedef float f32x16 __attribute__((ext_vector_type(16)));
typedef unsigned u32x2 __attribute__((ext_vector_type(2)));
typedef unsigned u32x4 __attribute__((ext_vector_type(4)));
typedef __bf16 bf16x2_t __attribute__((ext_vector_type(2)));

constexpr int NTOK = 32768, DM = 1024, NBATCH = 8, SEQ = 4096;
constexpr int WIN = 2560, NGATE = 3072, NQG = WIN + NGATE;
constexpr int NEXP = 256, TOPK = 8;
constexpr int NASSIGN = NTOK * TOPK;
constexpr int MAXROWS = NASSIGN + NEXP * 256;
constexpr float ALPHA = 1.189207115002721f;
constexpr float C2 = 0.18033688011112042f;
constexpr float LN_EPS = 1e-5f;
constexpr float LOG2E = 1.4426950408889634f;
constexpr float NEG_INF = -__builtin_inff();

constexpr size_t MiB = (size_t)1 << 20;
constexpr size_t WS_W2T = 0;
constexpr size_t WS_X1F = 128 * MiB;
constexpr size_t WS_HIDS = 256 * MiB;
constexpr size_t WS_CTL = 272 * MiB;
constexpr size_t WS_WTQG = 273 * MiB;
constexpr size_t WS_WTKV = 284 * MiB;
constexpr size_t WS_WTBRD = 285 * MiB;
constexpr size_t WS_WTBRM = 285 * MiB + 256 * 1024;
constexpr size_t WS_WTBRX = 286 * MiB;
constexpr size_t WS_WTOUT = 287 * MiB;
constexpr size_t WS_WTRS = 289 * MiB;
constexpr size_t WS_WTSD = 291 * MiB;
constexpr size_t WS_ROPE = 292 * MiB;
constexpr size_t WS_KVM = 294 * MiB;
constexpr size_t WS_LSE = 296 * MiB;
constexpr size_t WS_EIDX = 297 * MiB;
constexpr size_t WS_GWT = 298 * MiB;
constexpr size_t WS_POS = 299 * MiB;
constexpr size_t WS_ROWTOK = 300 * MiB;
constexpr size_t WS_ROWW = 301 * MiB + 256 * 1024;
constexpr size_t WS_ROWY = 302 * MiB + 512 * 1024;
constexpr size_t WS_W1T = 304 * MiB;
constexpr size_t WS_XB = 560 * MiB;
constexpr size_t WS_ODIL = 560 * MiB;
constexpr size_t WS_YMOBA = 584 * MiB;
constexpr size_t WS_YMEM = 608 * MiB;
constexpr size_t WS_X1B = 560 * MiB;
constexpr size_t WS_QKV = 624 * MiB;
constexpr size_t WS_MERGED = 624 * MiB;
#ifdef SELFCHECK
constexpr size_t WS_YDIL = 976 * MiB;
#else
constexpr size_t WS_YDIL = 688 * MiB;
#endif
constexpr size_t WS_SCORES = 624 * MiB;
constexpr size_t WS_HID = 624 * MiB;
constexpr size_t WS_GATES = 784 * MiB;
constexpr size_t WS_MEMB = 976 * MiB;
constexpr size_t WS_Y = 304 * MiB;
constexpr float Y_SCALE = 16.0f;
constexpr size_t WS_END = 980 * MiB;
constexpr int CW_COUNT = 0;
constexpr int CW_QUEUE = 512;
constexpr int CW_RT = 520;
constexpr int CW_TILEE = 1024;
constexpr int CW_TILECB = 2560;
constexpr int CW_TILENV = 57344;
constexpr int CW_BAR = 4096;
constexpr int CW_KSUM = 8192;

__device__ __forceinline__ unsigned cvtpk(float lo, float hi) { f32x2 v = {lo, hi}; bf16x2_t b = __builtin_convertvector(v, bf16x2_t); return __builtin_bit_cast(unsigned, b); }
__device__ __forceinline__ float bflo(unsigned w) { return __uint_as_float(w << 16); }
__device__ __forceinline__ float bfhi(unsigned w) { return __uint_as_float(w & 0xffff0000u); }
__device__ __forceinline__ float fast_sigmoid(float x) { return __builtin_amdgcn_rcpf(1.0f + __builtin_amdgcn_exp2f(-x * LOG2E)); }
__device__ __forceinline__ float wave_sum(float v) {
#pragma unroll
    for (int o = 1; o < 64; o <<= 1) v += __shfl_xor(v, o);
    return v;
}
__device__ __forceinline__ u32x4 pack8(f32x4 a, f32x4 b) { u32x4 w; w.x = cvtpk(a[0], a[1]); w.y = cvtpk(a[2], a[3]); w.z = cvtpk(b[0], b[1]); w.w = cvtpk(b[2], b[3]); return w; }
__device__ __forceinline__ void unpack8(u32x4 w, f32x4& a, f32x4& b) { a = (f32x4){bflo(w.x), bfhi(w.x), bflo(w.y), bfhi(w.y)}; b = (f32x4){bflo(w.z), bfhi(w.z), bflo(w.w), bfhi(w.w)}; }
#define LDS_WAIT() asm volatile("s_waitcnt lgkmcnt(0)" ::: "memory")
#define VM_WAIT() asm volatile("s_waitcnt vmcnt(0)" ::: "memory")

namespace pg8 {
constexpr int BM = 256, BK = 64, HALF = 128, HTB = HALF * BK * 2, STAGE_BYTES = 8 * HTB;
__device__ __forceinline__ int lds_byte(int r, int c) { const int st = (r >> 4) * 2 + (c >> 5), rr = r & 15, cc = c & 31, ob = rr * 64 + cc * 2; return st * 1024 + (ob ^ (((ob >> 9) & 1) << 5)); }
__device__ __forceinline__ void stage_rc(int b, int& R, int& C) { const int st = b / 1024, sb = b % 1024, swz = sb ^ (((sb >> 9) & 1) << 5); R = (st >> 1) * 16 + swz / 64; C = (st & 1) * 32 + (swz % 64) / 2; }
__device__ __forceinline__ int perm32(int rho) { const int n = rho >> 4, i = rho & 15; return 8 * (i >> 2) + 4 * n + (i & 3); }
__device__ __forceinline__ int xcd_remap(int L, int nwg) { const int q = nwg / 8, r = nwg % 8, xcd = L % 8, off = L / 8; return (xcd < r ? xcd * (q + 1) : r * (q + 1) + (xcd - r) * q) + off; }

struct GUnit {
    const char* a; const char* b;
    int nt;
    int pm, pn, kind, aux;
    int hsA, hsB;
    unsigned offA[2], offB[2];
    unsigned offA1[2];
};
struct LaneGeom {
    int R[2], C[2], Rp[2];
    __device__ __forceinline__ void init(int tid) {
#pragma unroll
        for (int i = 0; i < 2; ++i) { stage_rc(tid * 16 + i * 8192, R[i], C[i]); Rp[i] = (R[i] & ~31) + perm32(R[i] & 31); }
    }
};
template <class Epi, class Sched, bool ALIGN_EPI>
__device__ __forceinline__ void gemm_phase(LAS unsigned char* lds, const Sched& S, const Epi& E) {
    int tid = threadIdx.x; asm volatile("" : "+v"(tid));
    const int wid = __builtin_amdgcn_readfirstlane(tid >> 6), lane = tid & 63, wr = wid >> 2, wc = wid & 3, fr = lane & 15, fq = lane >> 4;
    const unsigned ldsw = (unsigned)wid * 1024u;
    const int aoff = lds_byte(wr * 64 + fr, fq * 8), boff = lds_byte(wc * 32 + fr, fq * 8);
#define PG8_SA(b, h) (((b) * 2 + (h)) * HTB)
#define PG8_SB(b, h) ((4 + (b) * 2 + (h)) * HTB)
#define PG8_STAGE(bufoff, gbase, voff) do { _Pragma("unroll") for (int _i = 0; _i < 2; ++_i) \
        __builtin_amdgcn_global_load_lds((const unsigned*)((const char*)(gbase) + (voff)[_i]), (LAS unsigned*)(lds + (bufoff) + ldsw + _i * 8192), 16, 0, 0); } while (0)
#define PG8_LDA(dst, b, h) do { _Pragma("unroll") for (int m = 0; m < 4; ++m) _Pragma("unroll") for (int k = 0; k < 2; ++k) dst[m][k] = *(const LAS bf16x8*)(lds + PG8_SA(b, h) + aoff + m * 2048 + k * 1024); } while (0)
#define PG8_LDB(dst, b, h) do { _Pragma("unroll") for (int n = 0; n < 2; ++n) _Pragma("unroll") for (int k = 0; k < 2; ++k) dst[n][k] = *(const LAS bf16x8*)(lds + PG8_SB(b, h) + boff + n * 2048 + k * 1024); } while (0)
#define PG8_MMA(ai, bj, At, Bt) do { __builtin_amdgcn_s_setprio(1); _Pragma("unroll") for (int m = 0; m < 4; ++m) _Pragma("unroll") for (int n = 0; n < 2; ++n) _Pragma("unroll") for (int k = 0; k < 2; ++k) \
        acc[ai][bj][m][n] = __builtin_amdgcn_mfma_f32_16x16x32_bf16(Bt[n][k], At[m][k], acc[ai][bj][m][n], 0, 0, 0); __builtin_amdgcn_s_setprio(0); } while (0)
#define PG8_WAIT_V(n) asm volatile("s_waitcnt vmcnt(" #n ")" ::: "memory")
#define PG8_WAIT_L(n) asm volatile("s_waitcnt lgkmcnt(" #n ")" ::: "memory")
#define PG8_BAR __builtin_amdgcn_s_barrier()
#define PG8_SCHED __builtin_amdgcn_sched_barrier(0)
    GUnit cur, nxt; int ui = 0;
    if (!S.next(0, cur)) return;
    f32x4 acc[2][2][4][2];
#pragma unroll
    for (int a = 0; a < 2; ++a)
#pragma unroll
        for (int b = 0; b < 2; ++b)
#pragma unroll
            for (int m = 0; m < 4; ++m)
#pragma unroll
                for (int n = 0; n < 2; ++n) acc[a][b][m][n] = (f32x4){0.f, 0.f, 0.f, 0.f};
    bf16x8 At[4][2], B0[2][2], B1[2][2];
    constexpr bool GA = Sched::GATHER;
#define PG8_STA(bufoff, U, h, koff) do { if constexpr (GA) { if ((h) == 0) PG8_STAGE(bufoff, (U).a + (koff), (U).offA); else PG8_STAGE(bufoff, (U).a + (koff), (U).offA1); } \
        else PG8_STAGE(bufoff, (U).a + (koff) + (size_t)((h) * (U).hsA), (U).offA); } while (0)
#define PG8_STB(bufoff, U, h, koff) PG8_STAGE(bufoff, (U).b + (koff) + (size_t)((h) * (U).hsB), (U).offB)
    PG8_STB(PG8_SB(0, 0), cur, 0, 0); PG8_STB(PG8_SB(0, 1), cur, 1, 0); PG8_STA(PG8_SA(0, 0), cur, 0, 0); PG8_STA(PG8_SA(0, 1), cur, 1, 0);
    if (wr == 1) PG8_BAR;
    PG8_WAIT_V(2); PG8_BAR;
    PG8_STB(PG8_SB(1, 0), cur, 0, 128); PG8_STA(PG8_SA(1, 0), cur, 0, 128); PG8_STB(PG8_SB(1, 1), cur, 1, 128);
    PG8_WAIT_V(6); PG8_BAR;
    for (;;) {
        const bool has_next = S.next(ui + 1, nxt);
        if (!has_next) nxt = cur;
        const int nt = cur.nt;
        for (int t = 0; t < nt; t += 2) {
            const bool last = (t == nt - 2);
            const size_t k1 = (size_t)(t + 1) * 128;
            GUnit sel;
            sel.a = last ? nxt.a : cur.a + (size_t)(t + 2) * 128; sel.b = last ? nxt.b : cur.b + (size_t)(t + 2) * 128;
            sel.hsA = last ? nxt.hsA : cur.hsA; sel.hsB = last ? nxt.hsB : cur.hsB;
#pragma unroll
            for (int i = 0; i < 2; ++i) { sel.offA[i] = last ? nxt.offA[i] : cur.offA[i]; sel.offB[i] = last ? nxt.offB[i] : cur.offB[i]; if constexpr (GA) sel.offA1[i] = last ? nxt.offA1[i] : cur.offA1[i]; }
            PG8_LDB(B0, 0, 0); PG8_LDB(B1, 0, 1); PG8_SCHED; PG8_LDA(At, 0, 0); PG8_STA(PG8_SA(1, 1), cur, 1, k1);
            PG8_WAIT_V(8); PG8_WAIT_L(0); PG8_BAR; PG8_MMA(0, 0, At, B0); PG8_MMA(0, 1, At, B1); PG8_BAR; PG8_SCHED;
            PG8_LDA(At, 0, 1); PG8_STB(PG8_SB(0, 0), sel, 0, 0); PG8_STB(PG8_SB(0, 1), sel, 1, 0); PG8_STA(PG8_SA(0, 0), sel, 0, 0);
            PG8_WAIT_V(8); PG8_WAIT_L(0); PG8_BAR; PG8_MMA(1, 0, At, B0); PG8_MMA(1, 1, At, B1); PG8_BAR; PG8_SCHED;
            PG8_LDB(B0, 1, 0); PG8_LDB(B1, 1, 1); PG8_SCHED; PG8_LDA(At, 1, 0); PG8_STA(PG8_SA(0, 1), sel, 1, 0);
            PG8_WAIT_V(8); PG8_WAIT_L(0); PG8_BAR; PG8_MMA(0, 0, At, B0); PG8_MMA(0, 1, At, B1); PG8_BAR; PG8_SCHED;
            PG8_LDA(At, 1, 1); PG8_STB(PG8_SB(1, 0), sel, 0, 128); PG8_STB(PG8_SB(1, 1), sel, 1, 128); PG8_STA(PG8_SA(1, 0), sel, 0, 128);
            PG8_WAIT_V(8); PG8_WAIT_L(0); PG8_BAR; PG8_MMA(1, 0, At, B0); PG8_MMA(1, 1, At, B1); PG8_BAR; PG8_SCHED;
        }
        if constexpr (ALIGN_EPI) { if (wr == 0) PG8_BAR; }
        E(acc, cur, wr, wc, fr, fq);
        if (!has_next) break;
#pragma unroll
        for (int a = 0; a < 2; ++a)
#pragma unroll
            for (int b = 0; b < 2; ++b)
#pragma unroll
                for (int m = 0; m < 4; ++m)
#pragma unroll
                    for (int n = 0; n < 2; ++n) acc[a][b][m][n] = (f32x4){0.f, 0.f, 0.f, 0.f};
        cur = nxt; ++ui;
        if constexpr (ALIGN_EPI) { if (wr == 1) PG8_BAR; }
    }
    PG8_WAIT_V(0);
    if constexpr (!ALIGN_EPI) { if (wr == 0) PG8_BAR; }
    PG8_BAR;
#undef PG8_SA
#undef PG8_SB
#undef PG8_STAGE
#undef PG8_STA
#undef PG8_STB
#undef PG8_LDA
#undef PG8_LDB
#undef PG8_MMA
#undef PG8_WAIT_V
#undef PG8_WAIT_L
#undef PG8_BAR
#undef PG8_SCHED
}

__device__ __forceinline__ void tile_of(int wgid, int nM, int nN, int& pm, int& pn) {
    const int WGM = 8, nig = WGM * nN, gid = wgid / nig, fm = gid * WGM, gsz = (nM - fm) < WGM ? (nM - fm) : WGM;
    pm = fm + ((wgid % nig) % gsz); pn = (wgid % nig) / gsz;
}
__device__ __forceinline__ void dense_offsets(GUnit& u, const LaneGeom& g, int lda_bytes, int ldb_bytes, bool perm) {
    u.hsA = 128 * lda_bytes; u.hsB = 128 * ldb_bytes;
#pragma unroll
    for (int i = 0; i < 2; ++i) {
        u.offA[i] = (unsigned)(g.R[i] * lda_bytes + g.C[i] * 2); u.offA1[i] = 0u;
        u.offB[i] = (unsigned)((perm ? g.Rp[i] : g.R[i]) * ldb_bytes + g.C[i] * 2);
    }
}
}
using pg8::GUnit; using pg8::LaneGeom;

struct Params {
    const float* x; const float* mem; const int* positions;
    const float* w_in; const float* w_mem_kv; const float* w_gate; const float* b_gate;
    const float* w_br_dil; const float* w_br_moba; const float* w_br_mem; const float* w_out;
    const float* ln1_g; const float* ln1_b; const float* w_router; const float* router_bias;
    const float* w_e_gate; const float* w_e_up; const float* w_e_down;
    const float* w_s_gate; const float* w_s_up; const float* w_s_down; const float* ln2_g; const float* ln2_b;
    float* out; unsigned char* ws;
};

__device__ __forceinline__ void transpose_item(const float* W, int N, bf16_t* WT, int dld, int k0, int n0, int drow0, LAS float* scr, int lane) {
#pragma unroll 8
    for (int i = 0; i < 32; ++i) { const int kk = 2 * i + (lane >> 5); scr[kk * 33 + (lane & 31)] = W[(size_t)(k0 + kk) * N + n0 + (lane & 31)]; }
    LDS_WAIT(); asm volatile("" ::: "memory");
    const int c = lane & 7;
#pragma unroll
    for (int j = 0; j < 4; ++j) { const int n = (lane >> 3) + 8 * j; const LAS float* s = scr + (8 * c) * 33 + n;
        u32x4 o; o.x = cvtpk(s[0 * 33], s[1 * 33]); o.y = cvtpk(s[2 * 33], s[3 * 33]); o.z = cvtpk(s[4 * 33], s[5 * 33]); o.w = cvtpk(s[6 * 33], s[7 * 33]);
        *(u32x4*)(WT + (size_t)(drow0 + n) * dld + k0 + 8 * c) = o; }
    LDS_WAIT(); asm volatile("" ::: "memory");
}
__device__ __forceinline__ bool p0_seg(int& r, const float* W, int K, int N, bf16_t* WT, int dld, int mode  , int row_off, LAS float* scr, int lane) {
    const int nblk = N / 32, items = (K / 64) * nblk;
    if (r >= items) { r -= items; return false; }
    const int kb = r / nblk, nb = r % nblk, n0 = 32 * nb;
    const int drow0 = row_off + (mode == 0 ? n0 : 256 * (n0 >> 7) + (n0 & 127) + (mode == 2 ? 128 : 0));
    transpose_item(W, N, WT, dld, 64 * kb, n0, drow0, scr, lane);
    return true;
}
__device__ __forceinline__ void conv_load(f32x4 (&v)[16], const float* W, int N, int k0, int n0, int lane) {
#pragma unroll
    for (int i = 0; i < 16; ++i) v[i] = __builtin_nontemporal_load((const f32x4*)(W + (size_t)(k0 + 4 * i + (lane >> 4)) * N + n0 + 4 * (lane & 15)));
}
__device__ __forceinline__ void conv_store(const f32x4 (&v)[16], bf16_t* WT, int dld, int k0, int drow0, LAS float* scr, int lane) {
#pragma unroll
    for (int i = 0; i < 16; ++i) { LAS float* s = scr + (4 * i + (lane >> 4)) * 65 + 4 * (lane & 15); s[0] = v[i][0]; s[1] = v[i][1]; s[2] = v[i][2]; s[3] = v[i][3]; }
    LDS_WAIT(); asm volatile("" ::: "memory");
    const int c = lane & 7;
#pragma unroll
    for (int j = 0; j < 8; ++j) { const int n = (lane >> 3) + 8 * j; const LAS float* s = scr + (8 * c) * 65 + n;
        u32x4 o; o.x = cvtpk(s[0 * 65], s[1 * 65]); o.y = cvtpk(s[2 * 65], s[3 * 65]); o.z = cvtpk(s[4 * 65], s[5 * 65]); o.w = cvtpk(s[6 * 65], s[7 * 65]);
        *(u32x4*)(WT + (size_t)(drow0 + n) * dld + k0 + 8 * c) = o; }
    LDS_WAIT(); asm volatile("" ::: "memory");
}
__device__ __forceinline__ void conv_chunk(const Params& P, unsigned char* ws, int c, LAS float* scr, int wave, int lane) {
    const int e = c / 3, which = c - 3 * e;
    const float* W; bf16_t* WT; int N, dld, nbn, rowoff;
    if (which == 0) { W = P.w_e_gate + (size_t)e * 1024 * 256; WT = (bf16_t*)(ws + WS_W1T) + (size_t)e * 512 * 1024; N = 256; dld = 1024; nbn = 4; rowoff = 0; }
    else if (which == 1) { W = P.w_e_up + (size_t)e * 1024 * 256; WT = (bf16_t*)(ws + WS_W1T) + (size_t)e * 512 * 1024; N = 256; dld = 1024; nbn = 4; rowoff = 128; }
    else { W = P.w_e_down + (size_t)e * 256 * 1024; WT = (bf16_t*)(ws + WS_W2T) + (size_t)e * 1024 * 256; N = 1024; dld = 256; nbn = 16; rowoff = 0; }
#define CONV_K0(t) (64 * ((t) / nbn))
#define CONV_N0(t) (64 * ((t) % nbn))
#define CONV_DROW(t) (which == 2 ? CONV_N0(t) : 256 * (CONV_N0(t) >> 7) + (CONV_N0(t) & 127) + rowoff)
    f32x4 va[16], vb[16];
    conv_load(va, W, N, CONV_K0(wave), CONV_N0(wave), lane);
#pragma unroll 1
    for (int q = 0; q < 8; q += 2) {
        const int t0 = wave + 8 * q, t1 = t0 + 8, t2 = t0 + 16;
        conv_load(vb, W, N, CONV_K0(t1), CONV_N0(t1), lane);
        conv_store(va, WT, dld, CONV_K0(t0), CONV_DROW(t0), scr, lane);
        if (q + 2 < 8) conv_load(va, W, N, CONV_K0(t2), CONV_N0(t2), lane);
        conv_store(vb, WT, dld, CONV_K0(t1), CONV_DROW(t1), scr, lane);
    }
#undef CONV_K0
#undef CONV_N0
#undef CONV_DROW
}
constexpr int CONV_CHUNKS = 3 * NEXP;
__device__ __forceinline__ void p0_prologue(const Params& P, LAS unsigned char* lds, int gw, int NGW, int gtid, int NTHR, int lane, int wave) {
    unsigned char* ws = P.ws;
    LAS float* scr = (LAS float*)(lds + wave * 16384);
    constexpr int SMALL_ITEMS = 1280 + 1536 + 256 + 64 + 192 + 128 + 512 + 128 + 128 + 128 + 128;
    constexpr int EXP_ITEMS = 128;
    constexpr int NITEMS = SMALL_ITEMS;
    for (int it = gw; it < NITEMS; it += NGW) {
        int r = it;
        if (r < SMALL_ITEMS) {
            if (p0_seg(r, P.w_in, 1024, WIN, (bf16_t*)(ws + WS_WTQG), 1024, 0, 0, scr, lane)) continue;
            if (p0_seg(r, P.w_gate, 1024, NGATE, (bf16_t*)(ws + WS_WTQG), 1024, 0, WIN, scr, lane)) continue;
            if (p0_seg(r, P.w_mem_kv, 1024, 512, (bf16_t*)(ws + WS_WTKV), 1024, 0, 0, scr, lane)) continue;
            if (p0_seg(r, P.w_br_dil, 128, 1024, (bf16_t*)(ws + WS_WTBRD), 128, 0, 0, scr, lane)) continue;
            if (p0_seg(r, P.w_br_moba, 384, 1024, (bf16_t*)(ws + WS_WTBRM), 384, 0, 0, scr, lane)) continue;
            if (p0_seg(r, P.w_br_mem, 256, 1024, (bf16_t*)(ws + WS_WTBRX), 256, 0, 0, scr, lane)) continue;
            if (p0_seg(r, P.w_out, 1024, 1024, (bf16_t*)(ws + WS_WTOUT), 1024, 0, 0, scr, lane)) continue;
            if (p0_seg(r, P.w_router, 1024, 256, (bf16_t*)(ws + WS_WTRS), 1024, 0, 0, scr, lane)) continue;
            if (p0_seg(r, P.w_s_gate, 1024, 256, (bf16_t*)(ws + WS_WTRS), 1024, 1, 256, scr, lane)) continue;
            if (p0_seg(r, P.w_s_up, 1024, 256, (bf16_t*)(ws + WS_WTRS), 1024, 2, 256, scr, lane)) continue;
            p0_seg(r, P.w_s_down, 256, 1024, (bf16_t*)(ws + WS_WTSD), 256, 0, 0, scr, lane);
        } else {
            r -= SMALL_ITEMS;
            const int which = r / (NEXP * EXP_ITEMS); r -= which * (NEXP * EXP_ITEMS);
            const int e = r / EXP_ITEMS; r -= e * EXP_ITEMS;
            if (which == 0) p0_seg(r, P.w_e_gate + (size_t)e * 1024 * 256, 1024, 256, (bf16_t*)(ws + WS_W1T) + (size_t)e * 512 * 1024, 1024, 1, 0, scr, lane);
            else if (which == 1) p0_seg(r, P.w_e_up + (size_t)e * 1024 * 256, 1024, 256, (bf16_t*)(ws + WS_W1T) + (size_t)e * 512 * 1024, 1024, 2, 0, scr, lane);
            else p0_seg(r, P.w_e_down + (size_t)e * 256 * 1024, 256, 1024, (bf16_t*)(ws + WS_W2T) + (size_t)e * 1024 * 256, 256, 0, 0, scr, lane);
        }
    }
    for (int c = gtid; c < NTOK * DM / 8; c += NTHR) { const f32x4 a = *(const f32x4*)(P.x + (size_t)c * 8), b = *(const f32x4*)(P.x + (size_t)c * 8 + 4); *(u32x4*)((bf16_t*)(ws + WS_XB) + (size_t)c * 8) = pack8(a, b); }
    for (int c = gtid; c < 2048 * DM / 8; c += NTHR) { const f32x4 a = *(const f32x4*)(P.mem + (size_t)c * 8), b = *(const f32x4*)(P.mem + (size_t)c * 8 + 4); *(u32x4*)((bf16_t*)(ws + WS_MEMB) + (size_t)c * 8) = pack8(a, b); }
    for (int tkn = gtid; tkn < NTOK; tkn += NTHR) {
        const double p = (double)P.positions[tkn]; float* o = (float*)(ws + WS_ROPE) + (size_t)tkn * 16;
#define ROPE_J(j, f) { const double a = p * (double)(f); const double rv = a * 0.15915494309189535; const double fr_ = rv - __builtin_rint(rv); const float ang = (float)(fr_ * 6.283185307179586); o[j] = cosf(ang); o[8 + j] = sinf(ang); }
        ROPE_J(0, 1.0f) ROPE_J(1, 0.1939227432012558f) ROPE_J(2, 0.03760603070259094f) ROPE_J(3, 0.007292664609849453f)
        ROPE_J(4, 0.0014142135623842478f) ROPE_J(5, 0.00027424818836152554f) ROPE_J(6, 5.318296098266728e-05f) ROPE_J(7, 1.0313386155758053e-05f)
#undef ROPE_J
    }
    unsigned* ctl = (unsigned*)(ws + WS_CTL);
    for (int i = gtid; i < 8192 + 49152; i += NTHR) ctl[i] = 0u;
}

struct SchedP1 {
    static constexpr bool GATHER = false;
    LaneGeom g; int G, c; const unsigned char* ws;
    __device__ __forceinline__ bool next(int i, GUnit& u) const {
        const int L = i * G + c; if (L >= 2816 + 16) return false;
        if (L < 2816) { const int wgid = pg8::xcd_remap(L, 2816); pg8::tile_of(wgid, 128, 22, u.pm, u.pn);
            u.a = (const char*)(ws + WS_XB) + (size_t)u.pm * 256 * 2048; u.b = (const char*)(ws + WS_WTQG) + (size_t)u.pn * 256 * 2048; u.kind = u.pn < 10 ? 0 : 1; }
        else { const int j = L - 2816; u.pm = j >> 1; u.pn = j & 1; u.kind = 2;
            u.a = (const char*)(ws + WS_MEMB) + (size_t)u.pm * 256 * 2048; u.b = (const char*)(ws + WS_WTKV) + (size_t)u.pn * 256 * 2048; }
        u.nt = 16; u.aux = 0; pg8::dense_offsets(u, g, 2048, 2048, true); return true;
    }
};
struct EpiP1 {
    bf16_t* qkv; bf16_t* gates; bf16_t* kvm; const float* bgate; const float* rope; float* ksum;
    __device__ __forceinline__ void operator()(const f32x4 (&acc)[2][2][4][2], const GUnit& u, int wr, int wc, int fr, int fq) const {
        const int row0 = u.pm * 256 + wr * 64 + fr;
        if (u.kind == 0) {
            const int cb0 = u.pn * 256 + 32 * wc;
            const bool even = (wc & 1) == 0;
            const int head0 = cb0 >> 6, head1 = (cb0 + 128) >> 6;
            const bool rh0 = head0 < 12 || (head0 >= 18 && head0 < 30), rh1 = head1 < 12 || (head1 >= 18 && head1 < 30);
            const bool anyrot = even && (rh0 || rh1);
            f32x4 cs0[2] = {{0.f, 0.f, 0.f, 0.f}, {0.f, 0.f, 0.f, 0.f}}, cs1[2] = {{0.f, 0.f, 0.f, 0.f}, {0.f, 0.f, 0.f, 0.f}};
#pragma unroll
            for (int ai = 0; ai < 2; ++ai) {
                f32x4 rc[4][4];
                if (anyrot) {
#pragma unroll
                    for (int m = 0; m < 4; ++m) { const float* rp = rope + (size_t)(row0 + 128 * ai + 16 * m) * 16;
#pragma unroll
                        for (int q = 0; q < 4; ++q) rc[m][q] = *(const f32x4*)(rp + 4 * q); }
                    asm volatile("" ::: "memory");
                }
#pragma unroll
                for (int bj = 0; bj < 2; ++bj) {
                    const int colbase = cb0 + 128 * bj, head = bj == 0 ? head0 : head1;
                    const bool rot = even && (bj == 0 ? rh0 : rh1);
                    const bool qhead = head < 6 || (head >= 18 && head < 24) || head >= 36;
                    const bool khead = head >= 24 && head < 30;
                    const float sc = qhead ? C2 : 1.0f;
#pragma unroll
                    for (int m = 0; m < 4; ++m) {
                        const int row = row0 + 128 * ai + 16 * m;
                        f32x4 v0 = acc[ai][bj][m][0], v1 = acc[ai][bj][m][1];
                        if (rot) {
                            f32x4 p0, p1;
#pragma unroll
                            for (int e = 0; e < 4; ++e) { p0[e] = __shfl_xor(v0[e], 16); p1[e] = __shfl_xor(v1[e], 16); }
                            if (fq == 0) { v0 = v0 * rc[m][0] - p0 * rc[m][2]; v1 = v1 * rc[m][1] - p1 * rc[m][3]; }
                            else if (fq == 1) { v0 = v0 * rc[m][0] + p0 * rc[m][2]; v1 = v1 * rc[m][1] + p1 * rc[m][3]; }
                        }
                        v0 = v0 * sc; v1 = v1 * sc;
                        if (khead) { cs0[bj] += v0; cs1[bj] += v1; }
                        *(u32x4*)(qkv + (size_t)row * WIN + colbase + 8 * fq) = pack8(v0, v1);
                    }
                }
            }
#pragma unroll
            for (int bj = 0; bj < 2; ++bj) {
                const int colbase = cb0 + 128 * bj, head = bj == 0 ? head0 : head1;
                if (head >= 24 && head < 30) {
                    f32x4 a = cs0[bj], b = cs1[bj];
#pragma unroll
                    for (int e = 0; e < 4; ++e) {
#pragma unroll
                        for (int o = 1; o < 16; o <<= 1) { a[e] += __shfl_xor(a[e], o); b[e] += __shfl_xor(b[e], o); }
                    }
                    int fq_ = fq; asm volatile("" : "+v"(fq_));
                    if (fr == 0) { float* kp = ksum + ((size_t)u.pm * 6 + (head - 24)) * 64 + (colbase & 63) + 8 * fq_;
#pragma unroll
                        for (int e = 0; e < 4; ++e) { atomicAdd(kp + e, a[e]); atomicAdd(kp + 4 + e, b[e]); } }
                }
            }
        } else if (u.kind == 1) {
#pragma unroll
            for (int bj = 0; bj < 2; ++bj) {
                const int col = (u.pn - 10) * 256 + 128 * bj + 32 * wc + 8 * fq;
                const f32x4 b0 = *(const f32x4*)(bgate + col), b1 = *(const f32x4*)(bgate + col + 4);
#pragma unroll
                for (int ai = 0; ai < 2; ++ai)
#pragma unroll
                    for (int m = 0; m < 4; ++m) {
                        const int row = row0 + 128 * ai + 16 * m;
                        f32x4 v0 = acc[ai][bj][m][0] + b0, v1 = acc[ai][bj][m][1] + b1;
#pragma unroll
                        for (int e = 0; e < 4; ++e) { v0[e] = fast_sigmoid(v0[e]); v1[e] = fast_sigmoid(v1[e]); }
                        *(u32x4*)(gates + (size_t)row * NGATE + col) = pack8(v0, v1);
                    }
            }
        } else {
#pragma unroll
            for (int bj = 0; bj < 2; ++bj) {
                const int col = u.pn * 256 + 128 * bj + 32 * wc + 8 * fq;
#pragma unroll
                for (int ai = 0; ai < 2; ++ai)
#pragma unroll
                    for (int m = 0; m < 4; ++m) { const int row = row0 + 128 * ai + 16 * m; *(u32x4*)(kvm + (size_t)row * 512 + col) = pack8(acc[ai][bj][m][0], acc[ai][bj][m][1]); }
            }
        }
    }
};

struct SchedP3 {
    static constexpr bool GATHER = false;
    LaneGeom g; int G, c; const unsigned char* ws;
    __device__ __forceinline__ bool next(int i, GUnit& u) const {
        const int i3 = i / 3, br = i - 3 * i3; const int L = i3 * G + c; if (L >= 512) return false;
        const int wgid = pg8::xcd_remap(L, 512); pg8::tile_of(wgid, 128, 4, u.pm, u.pn);
        u.kind = br; u.aux = 0;
        int kb; size_t abase, bbase;
        if (br == 0) { kb = 128; abase = WS_YDIL; bbase = WS_WTBRD; } else if (br == 1) { kb = 384; abase = WS_YMOBA; bbase = WS_WTBRM; } else { kb = 256; abase = WS_YMEM; bbase = WS_WTBRX; }
        u.nt = kb / 64;
        u.a = (const char*)(ws + abase) + (size_t)u.pm * 256 * kb * 2; u.b = (const char*)(ws + bbase) + (size_t)u.pn * 256 * kb * 2;
        pg8::dense_offsets(u, g, kb * 2, kb * 2, true); return true;
    }
};
struct EpiP3 {
    const bf16_t* gates; bf16_t* merged;
    __device__ __forceinline__ void operator()(const f32x4 (&acc)[2][2][4][2], const GUnit& u, int wr, int wc, int fr, int fq) const {
        const int row0 = u.pm * 256 + wr * 64 + fr, col0 = u.pn * 256 + 32 * wc + 8 * fq;
#pragma unroll
        for (int ai = 0; ai < 2; ++ai) {
            u32x4 gv[4][2], ov[4][2];
#pragma unroll
            for (int m = 0; m < 4; ++m)
#pragma unroll
                for (int bj = 0; bj < 2; ++bj) { const size_t row = (size_t)(row0 + 128 * ai + 16 * m);
                    gv[m][bj] = *(const u32x4*)(gates + row * NGATE + u.kind * 1024 + col0 + 128 * bj);
                    ov[m][bj] = u.kind != 0 ? *(const u32x4*)(merged + row * DM + col0 + 128 * bj) : (u32x4){0u, 0u, 0u, 0u}; }
            asm volatile("" ::: "memory");
#pragma unroll
            for (int m = 0; m < 4; ++m)
#pragma unroll
                for (int bj = 0; bj < 2; ++bj) { const size_t row = (size_t)(row0 + 128 * ai + 16 * m);
                    f32x4 g0, g1, o0, o1; unpack8(gv[m][bj], g0, g1); unpack8(ov[m][bj], o0, o1);
                    *(u32x4*)(merged + row * DM + col0 + 128 * bj) = pack8(o0 + g0 * acc[ai][bj][m][0], o1 + g1 * acc[ai][bj][m][1]); }
            asm volatile("" ::: "memory");
        }
    }
};

struct SchedP4 {
    static constexpr bool GATHER = false;
    LaneGeom g; int G, c; const unsigned char* ws;
    __device__ __forceinline__ bool next(int i, GUnit& u) const {
        const int L = i * G + c; if (L >= 512) return false;
        const int wgid = pg8::xcd_remap(L, 512); pg8::tile_of(wgid, 128, 4, u.pm, u.pn);
        u.kind = 0; u.aux = 0; u.nt = 16;
        u.a = (const char*)(ws + WS_MERGED) + (size_t)u.pm * 256 * 2048; u.b = (const char*)(ws + WS_WTOUT) + (size_t)u.pn * 256 * 2048;
        pg8::dense_offsets(u, g, 2048, 2048, false); return true;
    }
};
struct EpiP4 {
    const float* x; float* h1;
    __device__ __forceinline__ void operator()(const f32x4 (&acc)[2][2][4][2], const GUnit& u, int wr, int wc, int fr, int fq) const {
        const int row0 = u.pm * 256 + wr * 64 + fr, col0 = u.pn * 256 + wc * 32 + 4 * fq;
#pragma unroll
        for (int ai = 0; ai < 2; ++ai) {
            f32x4 xv[4][2][2];
#pragma unroll
            for (int m = 0; m < 4; ++m) { const size_t off = (size_t)(row0 + 128 * ai + 16 * m) * DM + col0;
#pragma unroll
                for (int bj = 0; bj < 2; ++bj)
#pragma unroll
                    for (int n = 0; n < 2; ++n) xv[m][bj][n] = *(const f32x4*)(x + off + bj * 128 + n * 16); }
            asm volatile("" ::: "memory");
#pragma unroll
            for (int m = 0; m < 4; ++m) { const size_t off = (size_t)(row0 + 128 * ai + 16 * m) * DM + col0;
#pragma unroll
                for (int bj = 0; bj < 2; ++bj)
#pragma unroll
                    for (int n = 0; n < 2; ++n) *(f32x4*)(h1 + off + bj * 128 + n * 16) = xv[m][bj][n] * ALPHA + acc[ai][bj][m][n]; }
            asm volatile("" ::: "memory");
        }
    }
};

struct SchedP6 {
    static constexpr bool GATHER = false;
    LaneGeom g; int G, c; const unsigned char* ws;
    __device__ __forceinline__ bool next(int i, GUnit& u) const {
        const int L = i * G + c; if (L >= 384) return false;
        const int wgid = pg8::xcd_remap(L, 384); pg8::tile_of(wgid, 128, 3, u.pm, u.pn);
        u.kind = u.pn == 0 ? 0 : 1; u.aux = 0; u.nt = 16;
        u.a = (const char*)(ws + WS_X1B) + (size_t)u.pm * 256 * 2048; u.b = (const char*)(ws + WS_WTRS) + (size_t)u.pn * 256 * 2048;
        pg8::dense_offsets(u, g, 2048, 2048, u.pn != 0); return true;
    }
};
__device__ __forceinline__ void swiglu_store(const f32x4 (&acc)[2][2][4][2], bf16_t* hid, size_t row_base  , int hcol0, int wr, int wc, int fr, int fq) {
#pragma unroll
    for (int ai = 0; ai < 2; ++ai)
#pragma unroll
        for (int m = 0; m < 4; ++m) {
            const size_t row = row_base + 128 * ai + 64 * wr + 16 * m + fr;
            f32x4 h0, h1;
#pragma unroll
            for (int e = 0; e < 4; ++e) { const float g0 = acc[ai][0][m][0][e], g1 = acc[ai][0][m][1][e];
                h0[e] = g0 * fast_sigmoid(g0) * acc[ai][1][m][0][e]; h1[e] = g1 * fast_sigmoid(g1) * acc[ai][1][m][1][e]; }
            *(u32x4*)(hid + row * 256 + hcol0 + 32 * wc + 8 * fq) = pack8(h0, h1);
        }
}
struct EpiP6 {
    float* scores; bf16_t* hids;
    __device__ __forceinline__ void operator()(const f32x4 (&acc)[2][2][4][2], const GUnit& u, int wr, int wc, int fr, int fq) const {
        if (u.kind == 0) {
            const int row0 = u.pm * 256 + wr * 64 + fr, col0 = wc * 32 + 4 * fq;
#pragma unroll
            for (int ai = 0; ai < 2; ++ai)
#pragma unroll
                for (int m = 0; m < 4; ++m) { const size_t off = (size_t)(row0 + 128 * ai + 16 * m) * 256 + col0;
#pragma unroll
                    for (int bj = 0; bj < 2; ++bj)
#pragma unroll
                        for (int n = 0; n < 2; ++n) { f32x4 v = acc[ai][bj][m][n];
#pragma unroll
                            for (int e = 0; e < 4; ++e) v[e] = 1.0f / (1.0f + __expf(-v[e]));
                            *(f32x4*)(scores + off + bj * 128 + n * 16) = v; } }
        } else swiglu_store(acc, hids, (size_t)u.pm * 256, 128 * (u.pn - 1), wr, wc, fr, fq);
    }
};

struct SchedP9 {
    static constexpr bool GATHER = true;
    LaneGeom g; int G, c; const unsigned char* ws; int nwg; const LAS unsigned short* tile_e;
    __device__ __forceinline__ bool next(int i, GUnit& u) const {
        const int L = i * G + c; if (L >= nwg) return false;
        const int wgid = pg8::xcd_remap(L, nwg); const int rt = wgid >> 1, p = wgid & 1;
        const int e = __builtin_amdgcn_readfirstlane((int)tile_e[rt]);
        u.pm = rt; u.pn = p; u.kind = 0; u.aux = e; u.nt = 16;
        u.a = (const char*)(ws + WS_X1B); u.b = (const char*)(ws + WS_W1T) + (size_t)e * (512 * 2048) + (size_t)p * 256 * 2048;
        const int* rtok = (const int*)(ws + WS_ROWTOK) + (size_t)rt * 256;
        u.hsA = 0; u.hsB = 128 * 2048;
#pragma unroll
        for (int k = 0; k < 2; ++k) { u.offA[k] = (unsigned)rtok[g.R[k]] * 2048u + (unsigned)(g.C[k] * 2); u.offA1[k] = (unsigned)rtok[128 + g.R[k]] * 2048u + (unsigned)(g.C[k] * 2); u.offB[k] = (unsigned)(g.Rp[k] * 2048 + g.C[k] * 2); }
        return true;
    }
};
struct EpiP9 {
    bf16_t* hid; const float* row_w;
    __device__ __forceinline__ void operator()(const f32x4 (&acc)[2][2][4][2], const GUnit& u, int wr, int wc, int fr, int fq) const {
        float rw[2][4];
#pragma unroll
        for (int ai = 0; ai < 2; ++ai)
#pragma unroll
            for (int m = 0; m < 4; ++m) rw[ai][m] = row_w[(size_t)u.pm * 256 + 128 * ai + 64 * wr + 16 * m + fr];
        asm volatile("" ::: "memory");
#pragma unroll
        for (int ai = 0; ai < 2; ++ai)
#pragma unroll
            for (int m = 0; m < 4; ++m) {
                const size_t row = (size_t)u.pm * 256 + 128 * ai + 64 * wr + 16 * m + fr; const float w = rw[ai][m];
                f32x4 h0, h1;
#pragma unroll
                for (int e = 0; e < 4; ++e) { const float g0 = acc[ai][0][m][0][e], g1 = acc[ai][0][m][1][e];
                    h0[e] = g0 * fast_sigmoid(g0) * acc[ai][1][m][0][e] * w; h1[e] = g1 * fast_sigmoid(g1) * acc[ai][1][m][1][e] * w; }
                *(u32x4*)(hid + row * 256 + 128 * u.pn + 32 * wc + 8 * fq) = pack8(h0, h1);
            }
    }
};

__device__ __forceinline__ unsigned pack4_fp8(f32x4 v) { unsigned w = 0u; w = __builtin_amdgcn_cvt_pk_fp8_f32(v[0] * Y_SCALE, v[1] * Y_SCALE, w, false); w = __builtin_amdgcn_cvt_pk_fp8_f32(v[2] * Y_SCALE, v[3] * Y_SCALE, w, true); return w; }
struct SchedP10 {
    static constexpr bool GATHER = false;
    LaneGeom g; int G, c; const unsigned char* ws; int nwg; const LAS unsigned short* tile_e; const LAS unsigned short* tile_nv; const LAS int* tile_cb;
    __device__ __forceinline__ bool next(int i, GUnit& u) const {
        const int L = i * G + c; if (L >= nwg) return false;
        u.nt = 4;
        const int wgid = pg8::xcd_remap(L, nwg); const int rt = wgid >> 2, pn = wgid & 3;
        const int e = __builtin_amdgcn_readfirstlane((int)tile_e[rt]);
        u.pm = rt; u.pn = pn; u.kind = __builtin_amdgcn_readfirstlane((int)tile_nv[rt]); u.aux = __builtin_amdgcn_readfirstlane(tile_cb[rt]);
        u.a = (const char*)(ws + WS_HID) + (size_t)rt * 256 * 512; u.b = (const char*)(ws + WS_W2T) + (size_t)e * (1024 * 512) + (size_t)pn * 256 * 512;
        pg8::dense_offsets(u, g, 512, 512, true);
        return true;
    }
};
struct EpiP10 {
    unsigned char* ws;
    __device__ __forceinline__ void operator()(const f32x4 (&acc)[2][2][4][2], const GUnit& u, int wr, int wc, int fr, int fq) const {
#pragma unroll
        for (int ai = 0; ai < 2; ++ai)
#pragma unroll
            for (int m = 0; m < 4; ++m) {
                const int r = 128 * ai + 64 * wr + 16 * m + fr;
                if (r < u.kind) { unsigned char* yp = ws + WS_Y + (size_t)(u.aux + r) * DM + u.pn * 256 + 32 * wc + 8 * fq;
#pragma unroll
                    for (int bj = 0; bj < 2; ++bj) { u32x2 w; w.x = pack4_fp8(acc[ai][bj][m][0]); w.y = pack4_fp8(acc[ai][bj][m][1]); *(u32x2*)(yp + 128 * bj) = w; } }
            }
    }
};
struct SchedP10s {
    static constexpr bool GATHER = false;
    LaneGeom g; int G, c; const unsigned char* ws; int shift;
    __device__ __forceinline__ bool next(int i, GUnit& u) const {
        const int L = i * G + ((c + shift) % G); if (L >= 512) return false;
        u.nt = 4; u.aux = 0; u.kind = 1;
        const int wgid = pg8::xcd_remap(L, 512); pg8::tile_of(wgid, 128, 4, u.pm, u.pn);
        u.a = (const char*)(ws + WS_HIDS) + (size_t)u.pm * 256 * 512; u.b = (const char*)(ws + WS_WTSD) + (size_t)u.pn * 256 * 512;
        pg8::dense_offsets(u, g, 512, 512, false);
        return true;
    }
};
struct EpiP10s {
    float* x1f; float* xo;
    __device__ __forceinline__ void operator()(const f32x4 (&acc)[2][2][4][2], const GUnit& u, int wr, int wc, int fr, int fq) const {
        const int row0 = u.pm * 256 + wr * 64 + fr, col0 = u.pn * 256 + wc * 32 + 4 * fq;
#pragma unroll
        for (int ai = 0; ai < 2; ++ai) {
            f32x4 xv[4][2][2];
#pragma unroll
            for (int m = 0; m < 4; ++m) { const size_t off = (size_t)(row0 + 128 * ai + 16 * m) * DM + col0;
#pragma unroll
                for (int bj = 0; bj < 2; ++bj)
#pragma unroll
                    for (int n = 0; n < 2; ++n) xv[m][bj][n] = *(const f32x4*)(x1f + off + bj * 128 + n * 16); }
            asm volatile("" ::: "memory");
#pragma unroll
            for (int m = 0; m < 4; ++m) { const size_t off = (size_t)(row0 + 128 * ai + 16 * m) * DM + col0;
#pragma unroll
                for (int bj = 0; bj < 2; ++bj)
#pragma unroll
                    for (int n = 0; n < 2; ++n) *(f32x4*)(xo + off + bj * 128 + n * 16) = xv[m][bj][n] * ALPHA + acc[ai][bj][m][n]; }
            asm volatile("" ::: "memory");
        }
    }
};

namespace att {
constexpr int NSLOT = 3, SLOTB = 8192, LDS_K = 0, LDS_V = NSLOT * SLOTB, LDS_WS = 2 * NSLOT * SLOTB, LDS_OST = LDS_WS + 8 * 256, LDS_BYTES = LDS_OST + 8 * 4096;
typedef short v4i16_t __attribute__((ext_vector_type(4)));
__device__ __forceinline__ int crow(int r, int hi) { return (r & 3) + 8 * (r >> 2) + 4 * hi; }
__device__ __forceinline__ void glds16(const void* gsrc, unsigned lds_dst) { unsigned keep;
    asm volatile("s_mov_b32 %0, m0\n\ts_mov_b32 m0, %2\n\ts_nop 0\n\tglobal_load_lds_dwordx4 %1, off\n\ts_mov_b32 m0, %0" : "=&s"(keep) : "v"(gsrc), "s"(lds_dst) : "memory"); }
__device__ __forceinline__ s16x4 vtr(LAS const char* p) { return __builtin_bit_cast(s16x4, __builtin_amdgcn_ds_read_tr16_b64_v4i16((LAS v4i16_t*)p)); }
#define ATT_MX3(a, b, c) __builtin_fmaxf(__builtin_fmaxf((a), (b)), (c))
__device__ __forceinline__ float rowmax32(const f32x16& p0, const f32x16& p1) {
    float a = ATT_MX3(p0[0], p0[1], p1[0]), b = ATT_MX3(p0[2], p0[3], p1[1]); a = ATT_MX3(a, p1[2], p1[3]);
#pragma unroll
    for (int r = 4; r < 16; r += 4) { a = ATT_MX3(a, p0[r], p0[r + 1]); b = ATT_MX3(b, p0[r + 2], p0[r + 3]); a = ATT_MX3(a, p1[r], p1[r + 1]); b = ATT_MX3(b, p1[r + 2], p1[r + 3]); }
    a = __builtin_fmaxf(a, b);
    auto rr = __builtin_amdgcn_permlane32_swap(__float_as_uint(a), __float_as_uint(a), false, false);
    return __builtin_fmaxf(__uint_as_float(rr[0]), __uint_as_float(rr[1]));
}
struct Desc {
    const bf16_t* q; long qs;
    const bf16_t* k; const bf16_t* v; long kvs; int key0;
    bf16_t* o; long os;
    float* lse; long lses;
    int nt;
    int mode;
    int qb;
    const float* ksum;
};
template <int MODE>
__device__ __forceinline__ void attn_unit(LAS char* shm, const Desc& D) {
    int tid = threadIdx.x; asm volatile("" : "+v"(tid));
    const int lane = tid & 63, r32 = lane & 31, hi = lane >> 5; const int wid = __builtin_amdgcn_readfirstlane(tid >> 6);
    const unsigned lds0 = (unsigned)(uintptr_t)shm;
    LAS float* wsf = (LAS float*)(shm + LDS_WS) + wid * 64;
    const bf16_t* Qw = D.q + (long)(wid * 32 + r32) * D.qs;
    bf16x8 qr[4];
#pragma unroll
    for (int d0 = 0; d0 < 4; ++d0) qr[d0] = *(const bf16x8*)(Qw + d0 * 16 + hi * 8);
    unsigned selmask = 0u;
    if constexpr (MODE == 1) {
        f32x16 gacc = {};
        const int n = lane & 31;
#pragma unroll
        for (int d0 = 0; d0 < 4; ++d0) {
            bf16x8 a = {};
            if (n < 16) { const float* kp = D.ksum + (size_t)n * (6 * 64) + 16 * d0 + 8 * hi; const f32x4 x0 = *(const f32x4*)kp, x1 = *(const f32x4*)(kp + 4); a = __builtin_bit_cast(bf16x8, pack8(x0 * (1.0f / 256.0f), x1 * (1.0f / 256.0f))); }
            gacc = __builtin_amdgcn_mfma_f32_32x32x16_bf16(a, qr[d0], gacc, 0, 0, 0);
        }
        float cv[16]; int cn[16];
#pragma unroll
        for (int r = 0; r < 8; ++r) { cv[r] = gacc[r]; cn[r] = crow(r, hi); cv[8 + r] = __shfl_xor(gacc[r], 32); cn[8 + r] = crow(r, hi ^ 1); }
#pragma unroll
        for (int rep = 0; rep < 3; ++rep) {
            float best = NEG_INF; int bi = -1;
#pragma unroll
            for (int c = 0; c < 16; ++c) { const bool ok = cn[c] < D.qb && !((selmask >> cn[c]) & 1u); const bool better = ok && (bi < 0 || cv[c] > best || (cv[c] == best && cn[c] < bi)); if (better) { best = cv[c]; bi = cn[c]; } }
            if (bi >= 0) selmask |= 1u << bi;
        }
    }
    float mhat = 0.f, lrun = 0.f; f32x16 o[2]; o[0] = f32x16{}; o[1] = f32x16{};
    f32x16 negm = f32x16{}; bool started = false;
    const int NT = D.nt;
    const LAS char* kp0 = (const LAS char*)shm + LDS_K + hi * 1024 + r32 * 16;
    const LAS char* vp0 = (const LAS char*)shm + LDS_V + ((lane >> 4) & 1) * 32 + (lane & 3) * 8 + (4 * hi + ((lane & 15) >> 2)) * 64;
    auto ktile = [&](int t) -> int { if constexpr (MODE == 1) return t < 4 ? (NT - 4 + t) : (t - 4); else return t; };
    auto dma = [&](int t, int slot) {
        const int kt = ktile(t);
        int krow = D.key0 + 64 * kt + lane; krow = krow < 0 ? 0 : krow;
        int vrow = D.key0 + 64 * kt + 16 * (wid & 3) + (lane >> 2); vrow = vrow < 0 ? 0 : vrow;
        glds16(D.k + (long)krow * D.kvs + wid * 8, (unsigned)__builtin_amdgcn_readfirstlane(lds0 + LDS_K + slot * SLOTB + wid * 1024));
        glds16(D.v + (long)vrow * D.kvs + (wid >> 2) * 32 + (lane & 3) * 8, (unsigned)__builtin_amdgcn_readfirstlane(lds0 + LDS_V + slot * SLOTB + wid * 1024));
    };
    dma(0, 0); dma(1, 1);
    int slot = 0, slot2 = 2;
#pragma unroll 1
    for (int t = 0; t < NT; ++t) {
        if (t + 1 < NT) asm volatile("s_waitcnt vmcnt(2) lgkmcnt(0)\n\ts_barrier" ::: "memory");
        else asm volatile("s_waitcnt vmcnt(0) lgkmcnt(0)\n\ts_barrier" ::: "memory");
        if (t + 2 < NT) dma(t + 2, slot2);
        const int kt = ktile(t);
        bool relevant = true; bool lane_sel = true;
        if constexpr (MODE == 1) {
            if (t < 4) relevant = (64 * t) <= (32 * wid + 31);
            else { lane_sel = (selmask >> (kt >> 2)) & 1u; relevant = __any(lane_sel); }
        }
        if constexpr (MODE == 2) { const int q0 = 32 * wid; relevant = (64 * kt - 128 <= q0 + 31) && (64 * kt - 65 >= q0 - 128) && (D.key0 + 64 * kt + 63 >= 0); }
        if (relevant) {
            f32x16 p0 = negm, p1 = negm;
            const LAS char* kb = kp0 + slot * SLOTB;
#pragma unroll
            for (int d0 = 0; d0 < 4; ++d0) {
                const bf16x8 b0 = *(const LAS bf16x8*)(kb + d0 * 2048), b1 = *(const LAS bf16x8*)(kb + d0 * 2048 + 512);
                p0 = __builtin_amdgcn_mfma_f32_32x32x16_bf16(b0, qr[d0], p0, 0, 0, 0); p1 = __builtin_amdgcn_mfma_f32_32x32x16_bf16(b1, qr[d0], p1, 0, 0, 0);
            }
            if constexpr (MODE == 1) {
                if (t < 4) { const int qrel = 32 * wid + r32, kb0 = 64 * t + 4 * hi;
#pragma unroll
                    for (int r = 0; r < 16; ++r) { const int kv = kb0 + (r & 3) + 8 * (r >> 2); if (kv > qrel) p0[r] = NEG_INF; if (kv + 32 > qrel) p1[r] = NEG_INF; } }
            }
            if constexpr (MODE == 2) {
                const int ql = D.qb + 32 * wid + r32, kl0 = D.key0 + 64 * kt + 4 * hi;
#pragma unroll
                for (int r = 0; r < 16; ++r) { const int kl = kl0 + (r & 3) + 8 * (r >> 2);
                    if (!(kl >= 0 && kl <= ql && ql - kl <= 128)) p0[r] = NEG_INF;
                    if (!(kl + 32 >= 0 && kl + 32 <= ql && ql - kl - 32 <= 128)) p1[r] = NEG_INF; }
            }
            float rm = rowmax32(p0, p1);
            if constexpr (MODE == 1) { if (!lane_sel) rm = NEG_INF; }
            if (!started || __any(rm > 0.f)) {
                const float dl = started ? __builtin_fmaxf(rm, 0.f) : (rm == NEG_INF ? 0.f : rm);
                mhat += dl;
#pragma unroll
                for (int r = 0; r < 16; ++r) { p0[r] -= dl; p1[r] -= dl; negm[r] = -mhat; }
                const float f = __builtin_amdgcn_exp2f(-dl); lrun *= f;
                if (started) {
                    if (hi == 0) wsf[r32] = f;
                    LDS_WAIT();
#pragma unroll
                    for (int r = 0; r < 16; ++r) { const float g = wsf[crow(r, hi)]; o[0][r] *= g; o[1][r] *= g; }
                }
                started = true;
            }
            float ps = 0.f;
#pragma unroll
            for (int r = 0; r < 16; ++r) { p0[r] = __builtin_amdgcn_exp2f(p0[r]); p1[r] = __builtin_amdgcn_exp2f(p1[r]); ps += p0[r] + p1[r]; }
            u32x4 pw0, pw1, pw2, pw3;
            pw0 = (u32x4){cvtpk(p0[0], p0[1]), cvtpk(p0[2], p0[3]), cvtpk(p0[4], p0[5]), cvtpk(p0[6], p0[7])};
            pw1 = (u32x4){cvtpk(p0[8], p0[9]), cvtpk(p0[10], p0[11]), cvtpk(p0[12], p0[13]), cvtpk(p0[14], p0[15])};
            pw2 = (u32x4){cvtpk(p1[0], p1[1]), cvtpk(p1[2], p1[3]), cvtpk(p1[4], p1[5]), cvtpk(p1[6], p1[7])};
            pw3 = (u32x4){cvtpk(p1[8], p1[9]), cvtpk(p1[10], p1[11]), cvtpk(p1[12], p1[13]), cvtpk(p1[14], p1[15])};
            if constexpr (MODE == 1) { if (!lane_sel) { ps = 0.f; pw0 = (u32x4){0u, 0u, 0u, 0u}; pw1 = pw0; pw2 = pw0; pw3 = pw0; } }
            lrun += ps;
            const LAS char* vb = vp0 + slot * SLOTB;
#pragma unroll
            for (int d0 = 0; d0 < 2; ++d0) {
                s16x4 lo[4], hh[4];
#pragma unroll
                for (int ks = 0; ks < 4; ++ks) { lo[ks] = vtr(vb + d0 * 4096 + ks * 1024); hh[ks] = vtr(vb + d0 * 4096 + ks * 1024 + 512); }
#define ATT_PK(k) (bf16x8){lo[k][0], lo[k][1], lo[k][2], lo[k][3], hh[k][0], hh[k][1], hh[k][2], hh[k][3]}
                o[d0] = __builtin_amdgcn_mfma_f32_32x32x16_bf16(__builtin_bit_cast(bf16x8, pw0), ATT_PK(0), o[d0], 0, 0, 0);
                o[d0] = __builtin_amdgcn_mfma_f32_32x32x16_bf16(__builtin_bit_cast(bf16x8, pw1), ATT_PK(1), o[d0], 0, 0, 0);
                o[d0] = __builtin_amdgcn_mfma_f32_32x32x16_bf16(__builtin_bit_cast(bf16x8, pw2), ATT_PK(2), o[d0], 0, 0, 0);
                o[d0] = __builtin_amdgcn_mfma_f32_32x32x16_bf16(__builtin_bit_cast(bf16x8, pw3), ATT_PK(3), o[d0], 0, 0, 0);
#undef ATT_PK
            }
        }
        slot = slot == NSLOT - 1 ? 0 : slot + 1; slot2 = slot2 == NSLOT - 1 ? 0 : slot2 + 1;
    }
    { auto rr = __builtin_amdgcn_permlane32_swap(__float_as_uint(lrun), __float_as_uint(lrun), false, false); lrun = __uint_as_float(rr[0]) + __uint_as_float(rr[1]); }
    if (hi == 0) wsf[32 + r32] = lrun;
    if (D.lse != nullptr && hi == 0) D.lse[(long)(wid * 32 + r32) * D.lses] = mhat + __builtin_amdgcn_logf(lrun);
    LDS_WAIT();
    bf16_t* Ow = D.o + (long)(wid * 32) * D.os;
    {
        LAS bf16_t* stg = (LAS bf16_t*)(shm + LDS_OST) + wid * 2048;
#pragma unroll
        for (int r = 0; r < 16; ++r) { const int orow = crow(r, hi); const float rli = __builtin_amdgcn_rcpf(wsf[32 + orow]);
#pragma unroll
            for (int d0 = 0; d0 < 2; ++d0) stg[orow * 64 + d0 * 32 + r32] = (bf16_t)(cvtpk(o[d0][r] * rli, 0.f) & 0xffffu); }
        LDS_WAIT();
#pragma unroll
        for (int i = 0; i < 4; ++i) { const int row = i * 8 + (lane >> 3), ch = lane & 7; const u32x4 v = *(const LAS u32x4*)(stg + row * 64 + ch * 8); *(u32x4*)(Ow + (long)row * D.os + ch * 8) = v; }
    }
    asm volatile("s_waitcnt lgkmcnt(0)\n\ts_barrier" ::: "memory");
}
}


#ifdef SELFCHECK
constexpr int CW_CHK = 600;
__device__ __forceinline__ float ldbf(const bf16_t* p) { return __uint_as_float((unsigned)(*p) << 16); }
__device__ __forceinline__ float bfr(float f) { return __uint_as_float(cvtpk(f, 0.f) << 16); }
__device__ __forceinline__ int chk_token(int s) { const unsigned h = (unsigned)s * 2654435761u; int t = (int)((h >> 7) % NTOK); if (s < 64) t = (s & 7) * SEQ + (s >> 3) * 37; if (s >= 64 && s < 128) t = (s & 7) * SEQ + SEQ - 1 - (s >> 3); return t; }
__device__ __forceinline__ void chk_report(unsigned* ctl, int idx, bool bad, int lane) { const bool anybad = __any(bad); if (lane == 0) { atomicAdd(ctl + CW_CHK + 16 + idx, 1u); if (anybad) atomicAdd(ctl + CW_CHK + idx, 1u); } }
__device__ __forceinline__ float wave_max(float v) {
#pragma unroll
    for (int o = 1; o < 64; o <<= 1) v = __builtin_fmaxf(v, __shfl_xor(v, o));
    return v;
}
__device__ __forceinline__ void rope_cs(int pos, int j, float& c, float& s) {
    const float f = j == 0 ? 1.0f : j == 1 ? 0.1939227432012558f : j == 2 ? 0.03760603070259094f : j == 3 ? 0.007292664609849453f : j == 4 ? 0.0014142135623842478f : j == 5 ? 0.00027424818836152554f : j == 6 ? 5.318296098266728e-05f : 1.0313386155758053e-05f;
    const double a = (double)pos * (double)f, rv = a * 0.15915494309189535, fr_ = rv - __builtin_rint(rv); const float ang = (float)(fr_ * 6.283185307179586); c = cosf(ang); s = sinf(ang);
}
__device__ __forceinline__ float naive_proj(const float* xrow, const float* W, int K, int N, int c) { float acc = 0.f; for (int k = 0; k < K; ++k) acc += bfr(xrow[k]) * bfr(W[(size_t)k * N + c]); return acc; }
struct ChkKeys { int mode, B0, B1, B2, own, pos, dil, lstep; long stride; };
__device__ __forceinline__ const bf16_t* chk_key(const ChkKeys& K, int i, int l, const bf16_t* base) {
    if (K.mode == 5) { const int g = i >> 2; const int bsel = g == 0 ? K.B0 : g == 1 ? K.B1 : g == 2 ? K.B2 : K.own; const int key = bsel * 256 + (i & 3) * 64 + l; const bool valid = bsel >= 0 && (g != 3 || key <= K.pos); return valid ? base + (size_t)key * K.stride : nullptr; }
    if (K.mode == 6) { const int j = l + 64 * i; const bool valid = j <= 128 && j <= K.lstep; return valid ? base + (size_t)(K.pos - j * K.dil) * K.stride : nullptr; }
    return base + (size_t)(l + 64 * i) * K.stride;
}
__device__ __forceinline__ float naive_att(const ChkKeys& K, int NS, float qv, const bf16_t* kbase, const bf16_t* vbase, LAS float* scs, int lane, float& lse2) {
    float mx = NEG_INF;
    for (int i = 0; i < NS; ++i) { const bf16_t* kp = chk_key(K, i, lane, kbase); const bool v = kp != nullptr; const bf16_t* kq = v ? kp : kbase; float acc = 0.f;
        for (int d = 0; d < 64; ++d) acc += __shfl(qv, d) * ldbf(kq + d);
        const float a = v ? acc : NEG_INF; scs[i * 64 + lane] = a; mx = __builtin_fmaxf(mx, a); }
    mx = wave_max(mx); float l = 0.f;
    for (int i = 0; i < NS; ++i) { const float p = __builtin_amdgcn_exp2f(scs[i * 64 + lane] - mx); scs[i * 64 + lane] = p; l += p; }
    l = wave_sum(l); LDS_WAIT();
    float oacc = 0.f;
    for (int i = 0; i < NS; ++i) for (int sl = 0; sl < 64; ++sl) { const bf16_t* vp = chk_key(K, i, sl, vbase); if (vp != nullptr) oacc += scs[i * 64 + sl] * ldbf(vp + lane); }
    LDS_WAIT();
    lse2 = mx + __builtin_amdgcn_logf(l); return oacc / l;
}
__device__ __forceinline__ void selfcheck_a(const Params& P, unsigned char* ws, unsigned* ctl, LAS float* scs, int gw, int NGW, int lane) {
    const bf16_t* qkv = (const bf16_t*)(ws + WS_QKV);
    for (int s = gw; s < 2048; s += NGW) {
        const int t = chk_token(s), b = t / SEQ, pos = t % SEQ;
        { const int head = s % 40, c = head * 64 + lane;
          float v = naive_proj(P.x + (size_t)t * DM, P.w_in, DM, WIN, c);
          const bool rope_head = head < 12 || (head >= 18 && head < 30);
          const float partner = __shfl_xor(v, 8);
          if (rope_head && lane < 16) { float cs, sn; rope_cs(P.positions[t], lane & 7, cs, sn); v = lane < 8 ? v * cs - partner * sn : v * cs + partner * sn; }
          const bool qhead = head < 6 || (head >= 18 && head < 24) || head >= 36; if (qhead) v *= C2;
          const float got = ldbf(qkv + (size_t)t * WIN + c);
          chk_report(ctl, 1, !(fabsf(got - v) <= 0.02f * fabsf(v) + 0.01f), lane); }
        { const int c = (s % 48) * 64 + lane; const float z = naive_proj(P.x + (size_t)t * DM, P.w_gate, DM, NGATE, c) + P.b_gate[c]; const float v = 1.f / (1.f + expf(-z));
          const float got = ldbf((const bf16_t*)(ws + WS_GATES) + (size_t)t * NGATE + c);
          chk_report(ctl, 2, !(fabsf(got - v) <= 0.01f), lane); }
        { const int blk = s % 16, h = (s / 16) % 6; float acc = 0.f; for (int r = 0; r < 256; ++r) acc += ldbf(qkv + ((size_t)b * SEQ + blk * 256 + r) * WIN + 1536 + h * 64 + lane);
          const float got = ((const float*)(ctl + CW_KSUM))[(((size_t)b * 16 + blk) * 6 + h) * 64 + lane];
          chk_report(ctl, 3, !(fabsf(got - acc) <= 0.02f * fabsf(acc) + 0.3f), lane); }
        { const int mr = (int)(((unsigned)s * 40503u) % 2048u), c = (s % 8) * 64 + lane; const float v = naive_proj(P.mem + (size_t)mr * DM, P.w_mem_kv, DM, 512, c);
          const float got = ldbf((const bf16_t*)(ws + WS_KVM) + (size_t)mr * 512 + c);
          chk_report(ctl, 4, !(fabsf(got - v) <= 0.02f * fabsf(v) + 0.01f), lane); }
        { const int h = s % 6, own = pos >> 8;
          const float qv = ldbf(qkv + (size_t)t * WIN + 1152 + h * 64 + lane);
          float gate = NEG_INF;
          { float acc = 0.f; const int n = lane & 15; const float* kp = (const float*)(ctl + CW_KSUM) + (((size_t)b * 16 + n) * 6 + h) * 64;
            for (int d = 0; d < 64; ++d) acc += __shfl(qv, d) * bfr(kp[d] * (1.0f / 256.0f)); if (lane < own && lane < 16) gate = acc; }
          ChkKeys K; K.mode = 5; K.B0 = -1; K.B1 = -1; K.B2 = -1; K.own = own; K.pos = pos; K.dil = 1; K.lstep = 0; K.stride = WIN;
          for (int rep = 0; rep < 3; ++rep) { float best = NEG_INF; int bi = -1;
              for (int n = 0; n < 16; ++n) { const float gn = __shfl(gate, n); const bool ok = n < own && n != K.B0 && n != K.B1 && n != K.B2; if (ok && (bi < 0 || gn > best)) { best = gn; bi = n; } }
              if (rep == 0) K.B0 = bi; else if (rep == 1) K.B1 = bi; else K.B2 = bi; }
          float l2; const float want = naive_att(K, 16, qv, qkv + (size_t)b * SEQ * WIN + 1536 + h * 64, qkv + (size_t)b * SEQ * WIN + 1920 + h * 64, scs, lane, l2);
          const float got = ldbf((const bf16_t*)(ws + WS_YMOBA) + (size_t)t * 384 + h * 64 + lane);
          const float scale = wave_max(fabsf(want));
          chk_report(ctl, 5, !(fabsf(got - want) <= 0.03f * scale + 2e-3f), lane); }
        { const int hg = s & 1; float lg0 = 0.f, lg1 = 0.f, lg2 = 0.f, og0 = 0.f, og1 = 0.f, og2 = 0.f;
          for (int g = 0; g < 3; ++g) { const int hd = 2 * g + hg, dil = g == 0 ? 1 : g == 1 ? 4 : 16;
              ChkKeys K; K.mode = 6; K.B0 = K.B1 = K.B2 = -1; K.own = 0; K.pos = pos; K.dil = dil; K.lstep = pos / dil; K.stride = WIN;
              const float qv = ldbf(qkv + (size_t)t * WIN + hd * 64 + lane); float l2;
              const float o = naive_att(K, 3, qv, qkv + (size_t)b * SEQ * WIN + 384 + hd * 64, qkv + (size_t)b * SEQ * WIN + 768 + hd * 64, scs, lane, l2);
              if (g == 0) { og0 = o; lg0 = l2; } else if (g == 1) { og1 = o; lg1 = l2; } else { og2 = o; lg2 = l2; } }
          const float mm = __builtin_fmaxf(lg0, __builtin_fmaxf(lg1, lg2)); const float e0 = exp2f(lg0 - mm), e1 = exp2f(lg1 - mm), e2 = exp2f(lg2 - mm);
          const float want = (e0 * og0 + e1 * og1 + e2 * og2) / (e0 + e1 + e2);
          const float got = ldbf((const bf16_t*)(ws + WS_YDIL) + (size_t)t * 128 + hg * 64 + lane); const float scale = wave_max(fabsf(want));
          chk_report(ctl, 6, !(fabsf(got - want) <= 0.03f * scale + 2e-3f), lane); }
        { const int h = s & 3; const float qv = ldbf(qkv + (size_t)t * WIN + 2304 + h * 64 + lane);
          const bf16_t* kbase = (const bf16_t*)(ws + WS_KVM) + (size_t)b * 256 * 512 + h * 64;
          ChkKeys K; K.mode = 7; K.B0 = K.B1 = K.B2 = -1; K.own = 0; K.pos = 0; K.dil = 1; K.lstep = 0; K.stride = 512; float l2;
          const float want = naive_att(K, 4, qv, kbase, kbase + 256, scs, lane, l2);
          const float got = ldbf((const bf16_t*)(ws + WS_YMEM) + (size_t)t * 256 + h * 64 + lane); const float scale = wave_max(fabsf(want));
          chk_report(ctl, 7, !(fabsf(got - want) <= 0.03f * scale + 2e-3f), lane); }
    }
}
__device__ __forceinline__ void selfcheck_b(const Params& P, unsigned char* ws, unsigned* ctl, int gw, int NGW, int lane) {
    for (int s = gw; s < 2048; s += NGW) {
        const int t = chk_token(s);
        { const int c = (s % 16) * 64 + lane; const bf16_t* gates = (const bf16_t*)(ws + WS_GATES) + (size_t)t * NGATE;
          float p0 = 0.f, p1 = 0.f, p2 = 0.f;
          for (int k = 0; k < 128; ++k) p0 += ldbf((const bf16_t*)(ws + WS_YDIL) + (size_t)t * 128 + k) * bfr(P.w_br_dil[(size_t)k * DM + c]);
          for (int k = 0; k < 384; ++k) p1 += ldbf((const bf16_t*)(ws + WS_YMOBA) + (size_t)t * 384 + k) * bfr(P.w_br_moba[(size_t)k * DM + c]);
          for (int k = 0; k < 256; ++k) p2 += ldbf((const bf16_t*)(ws + WS_YMEM) + (size_t)t * 256 + k) * bfr(P.w_br_mem[(size_t)k * DM + c]);
          const float want = ldbf(gates + c) * p0 + ldbf(gates + 1024 + c) * p1 + ldbf(gates + 2048 + c) * p2, got = ldbf((const bf16_t*)(ws + WS_MERGED) + (size_t)t * DM + c);
          const float scale = wave_max(fabsf(want));
          chk_report(ctl, 8, !(fabsf(got - want) <= 0.03f * scale + 1e-3f), lane); }
        { const int c = (s % 16) * 64 + lane; float acc = 0.f; for (int k = 0; k < DM; ++k) acc += ldbf((const bf16_t*)(ws + WS_MERGED) + (size_t)t * DM + k) * bfr(P.w_out[(size_t)k * DM + c]);
          const float want = ALPHA * P.x[(size_t)t * DM + c] + acc, got = ((const float*)(ws + WS_X1F))[(size_t)t * DM + c];
          const float scale = wave_max(fabsf(acc));
          chk_report(ctl, 9, !(fabsf(got - want) <= 0.02f * scale + 1e-4f), lane); }
    }
}
#endif

#define XB_TMO      128
#define XB_XCNT(j)  (256  + 64 * (j))
#define XB_XSUB(j)  (1280 + 64 * (j))
#define XB_XGEN(j)  (2304 + 64 * (j))
#define XB_TOP      3328
#define XB_TOPGEN   3392
#define XCD_BAR_WORDS 3456
#define XB_SPIN_CAP (1u << 18)
__device__ __forceinline__ unsigned xb_ld(unsigned* p)              { return __hip_atomic_load(p, __ATOMIC_RELAXED, __HIP_MEMORY_SCOPE_AGENT); }
__device__ __forceinline__ unsigned xb_add(unsigned* p, unsigned v) { return __hip_atomic_fetch_add(p, v, __ATOMIC_RELAXED, __HIP_MEMORY_SCOPE_AGENT); }
__device__ __forceinline__ unsigned xb_xcc_id() { return (unsigned)__builtin_amdgcn_s_getreg((3 << 11) | 20) & 0xFu; }
#define XB_SPIN(cond, bar) do { unsigned _sp = 0; while (cond) { __builtin_amdgcn_s_sleep(1); \
    if ((++_sp & 255u) == 0u) { if (xb_ld(&(bar)[XB_TMO])) break; if (_sp > XB_SPIN_CAP) { atomicAdd(&(bar)[XB_TMO], 1u); break; } } } } while (0)
struct XcdBarrier { unsigned* bar; unsigned x; volatile LAS unsigned* st; };
__device__ __forceinline__ XcdBarrier xcd_barrier_post(unsigned* bar, volatile LAS unsigned* st) {
    XcdBarrier b; b.bar = bar; b.x = xb_xcc_id(); b.st = st;
    if (threadIdx.x == 0) (void)xb_add(&bar[XB_XCNT(b.x)], 1u);
    return b;
}
__device__ __forceinline__ void xcd_barrier_complete(unsigned* bar, unsigned x, unsigned& nloc, unsigned& nx) {
    const unsigned G = gridDim.x * gridDim.y * gridDim.z;
    unsigned sum, cnt, mine, sp = 0u;
    for (;;) {
        sum = 0u; cnt = 0u; mine = 0u;
#pragma unroll
        for (unsigned j = 0; j < 16; ++j) { const unsigned c = xb_ld(&bar[XB_XCNT(j)]); sum += c; cnt += (c > 0u) ? 1u : 0u; mine = (j == x) ? c : mine; }
        if (sum == G) break;
        __builtin_amdgcn_s_sleep(1);
        if ((++sp & 255u) == 0u) { if (xb_ld(&bar[XB_TMO])) break; if (sp > XB_SPIN_CAP) { atomicAdd(&bar[XB_TMO], 1u); break; } }
    }
    nloc = mine > 0u ? mine : 1u; nx = cnt > 0u ? cnt : 1u;
}
__device__ __forceinline__ void xcd_barrier(const XcdBarrier& b) {
    asm volatile("s_waitcnt vmcnt(0)" ::: "memory");
    __syncthreads();
    if (threadIdx.x == 0) {
        unsigned* bar = b.bar;
        __builtin_amdgcn_s_waitcnt(0);
        unsigned nloc = b.st[0], nx = b.st[1];
        if (nloc == 0u) { xcd_barrier_complete(bar, b.x, nloc, nx); b.st[0] = nloc; b.st[1] = nx; }
        const unsigned old = xb_add(&bar[XB_XSUB(b.x)], 1u);
        const unsigned gen = old / nloc;
        if (old + 1u == (gen + 1u) * nloc) {
            __builtin_amdgcn_fence(__ATOMIC_RELEASE, "agent");
            asm volatile("s_waitcnt vmcnt(0)" ::: "memory");
            const unsigned og = xb_add(&bar[XB_TOP], 1u);
            const unsigned tg = og / nx;
            if (og + 1u == (tg + 1u) * nx) xb_add(&bar[XB_TOPGEN], 1u);
            else XB_SPIN(xb_ld(&bar[XB_TOPGEN]) == tg, bar);
            __builtin_amdgcn_fence(__ATOMIC_ACQUIRE, "agent");
            xb_add(&bar[XB_XGEN(b.x)], 1u);
            asm volatile("s_waitcnt vmcnt(0)" ::: "memory");
        } else {
            XB_SPIN(xb_ld(&bar[XB_XGEN(b.x)]) == gen, bar);
            __builtin_amdgcn_fence(__ATOMIC_ACQUIRE, "agent");
            asm volatile("s_waitcnt vmcnt(0)" ::: "memory");
        }
    }
    __syncthreads();
}
constexpr int NWAVES = 8, NTHREADS = NWAVES * 64;
constexpr int RING_BYTES = 131072, CONV_SCR = 16640, MISC_OFF = 8 * CONV_SCR, LDS_BYTES = 147456;

#ifndef PHASE_MASK
#define PHASE_MASK 0xFFFF
#endif
#define PH(k) (((PHASE_MASK) >> (k)) & 1)
#ifndef REPEAT_MASK
#define REPEAT_MASK 0
#endif
#define NREP(k) ((((REPEAT_MASK) >> (k)) & 1) ? 2 : 1)
#ifndef ATT_MASK
#define ATT_MASK 7
#endif
#define ATT_EN(k) (((ATT_MASK) >> (k)) & 1)
__global__ void __launch_bounds__(NTHREADS, 2) fwd_megakernel(Params P) {
    extern __shared__ __attribute__((aligned(16))) unsigned char lds_raw[];
    cg::grid_group grid = cg::this_grid();
    LAS unsigned char* lds = (LAS unsigned char*)lds_raw;
    unsigned char* ws = P.ws;
    int tid = threadIdx.x, lane = tid & 63; const int wave = __builtin_amdgcn_readfirstlane(tid >> 6);
    const int G = gridDim.x, bx = blockIdx.x;
    const int gw = bx * NWAVES + wave, NGW = G * NWAVES, NTHR = G * NTHREADS; int gtid = bx * NTHREADS + tid;
#define LANE_REFRESH() do { tid = threadIdx.x; asm volatile("" : "+v"(tid)); lane = tid & 63; gtid = bx * NTHREADS + tid; } while (0)
    unsigned* ctl = (unsigned*)(ws + WS_CTL);

    if (tid < 4) ((LAS unsigned*)(lds + MISC_OFF + 16))[tid] = 0u;
    if constexpr (PH(0)) for (int rep_ = 0; rep_ < NREP(0); ++rep_) p0_prologue(P, lds, gw, NGW, gtid, NTHR, lane, wave);
    grid.sync();
    const XcdBarrier xbar = xcd_barrier_post(ctl + CW_BAR, (volatile LAS unsigned*)(lds + MISC_OFF + 16));
#define GRID_BAR() xcd_barrier(xbar)

    if constexpr (PH(1)) {
        LaneGeom geom; { int t_ = threadIdx.x; asm volatile("" : "+v"(t_)); geom.init(t_); }
        SchedP1 S{geom, G, bx, ws};
        EpiP1 E{(bf16_t*)(ws + WS_QKV), (bf16_t*)(ws + WS_GATES), (bf16_t*)(ws + WS_KVM), P.b_gate, (const float*)(ws + WS_ROPE), (float*)(ctl + CW_KSUM)};
        pg8::gemm_phase<EpiP1, SchedP1, true>(lds, S, E); if constexpr (NREP(1) == 2) { pg8::gemm_phase<EpiP1, SchedP1, true>(lds, S, E); }
    }
    GRID_BAR();

    LANE_REFRESH();
    if constexpr (PH(2)) {
        LAS int* qslot = (LAS int*)(lds + MISC_OFF);
        const bf16_t* qkv = (const bf16_t*)(ws + WS_QKV);
        for (int rep_ = 0; rep_ < NREP(2); ++rep_) {
#define ATT_POP(base, count) int idx; { if (tid == 0) qslot[0] = (int)atomicAdd(ctl + CW_QUEUE + 4 * rep_ + (base), 1u); __syncthreads(); idx = __builtin_amdgcn_readfirstlane(qslot[0]); __syncthreads(); } if (idx >= (count)) break;
#ifndef NCONV_WG
#define NCONV_WG 96
#endif
#define CONV_LOOP() for (;;) { int idx; { if (tid == 0) qslot[0] = (int)atomicAdd(ctl + CW_QUEUE + 3, 1u); __syncthreads(); idx = __builtin_amdgcn_readfirstlane(qslot[0]); __syncthreads(); } if (idx >= CONV_CHUNKS) break; \
            conv_chunk(P, ws, idx, (LAS float*)(lds + wave * CONV_SCR), wave, lane); }
        if (bx >= G - NCONV_WG) CONV_LOOP()
        if (ATT_EN(1)) for (;;) {
            ATT_POP(0, 768)
            att::Desc D;
            const int qb = 15 - idx / 48, bh = idx % 48, b = bh / 6, h = bh % 6;
            const size_t tok0 = (size_t)b * SEQ;
            D.q = qkv + (tok0 + 256 * qb) * WIN + 1152 + h * 64; D.qs = WIN;
            D.k = qkv + tok0 * WIN + 1536 + h * 64; D.v = qkv + tok0 * WIN + 1920 + h * 64; D.kvs = WIN; D.key0 = 0;
            D.o = (bf16_t*)(ws + WS_YMOBA) + (tok0 + 256 * qb) * 384 + h * 64; D.os = 384; D.lse = nullptr; D.lses = 0;
            D.nt = 4 * qb + 4; D.mode = 1; D.qb = qb; D.ksum = (const float*)(ctl + CW_KSUM) + ((size_t)b * 16 * 6 + h) * 64;
            att::attn_unit<1>((LAS char*)lds, D);
        }
        if (ATT_EN(2)) for (;;) {
            ATT_POP(1, 768)
            att::Desc D;
            const int bh = idx >> 4, sub = idx & 15, b = bh / 6, hd = bh % 6, gI = hd >> 1;
            const int dil = gI == 0 ? 1 : (gI == 1 ? 4 : 16);
            const int res = gI == 0 ? 0 : (gI == 1 ? (sub & 3) : sub), ub = gI == 0 ? sub : (gI == 1 ? (sub >> 2) : 0);
            const size_t tok0 = (size_t)b * SEQ + res;
            D.q = qkv + (tok0 + (size_t)256 * ub * dil) * WIN + hd * 64; D.qs = (long)dil * WIN;
            D.k = qkv + tok0 * WIN + 384 + hd * 64; D.v = qkv + tok0 * WIN + 768 + hd * 64; D.kvs = (long)dil * WIN; D.key0 = 256 * ub - 128;
            D.o = (bf16_t*)(ws + WS_ODIL) + (tok0 + (size_t)256 * ub * dil) * 384 + hd * 64; D.os = (long)dil * 384;
            D.lse = (float*)(ws + WS_LSE) + (tok0 + (size_t)256 * ub * dil) * 6 + hd; D.lses = (long)dil * 6;
            D.nt = 6; D.mode = 2; D.qb = 256 * ub; D.ksum = nullptr;
            att::attn_unit<2>((LAS char*)lds, D);
        }
        if (ATT_EN(0)) for (;;) {
            ATT_POP(2, 512)
            att::Desc D;
            const int b = idx >> 6, h = (idx >> 4) & 3, qblk = idx & 15;
            const size_t tok0 = (size_t)b * SEQ + 256 * qblk;
            const bf16_t* kvm = (const bf16_t*)(ws + WS_KVM) + (size_t)b * 256 * 512;
            D.q = qkv + tok0 * WIN + 2304 + h * 64; D.qs = WIN;
            D.k = kvm + h * 64; D.v = kvm + 256 + h * 64; D.kvs = 512; D.key0 = 0;
            D.o = (bf16_t*)(ws + WS_YMEM) + tok0 * 256 + h * 64; D.os = 256; D.lse = nullptr; D.lses = 0;
            D.nt = 4; D.mode = 0; D.qb = 0; D.ksum = nullptr;
            att::attn_unit<0>((LAS char*)lds, D);
        }
        CONV_LOOP()
        }
#undef ATT_POP
#undef CONV_LOOP
    }
    GRID_BAR();

    LANE_REFRESH();
    if constexpr (PH(3)) {
        const bf16_t* odil = (const bf16_t*)(ws + WS_ODIL); const float* lse = (const float*)(ws + WS_LSE); bf16_t* ydil = (bf16_t*)(ws + WS_YDIL);
        for (int tkn = gw; tkn < NTOK; tkn += NGW) {
            const int hg = lane >> 5, dd = (lane & 31) * 2;
            const float l0 = lse[(size_t)tkn * 6 + hg], l1 = lse[(size_t)tkn * 6 + 2 + hg], l2 = lse[(size_t)tkn * 6 + 4 + hg];
            const float mx = __builtin_fmaxf(l0, __builtin_fmaxf(l1, l2));
            const float e0 = __builtin_amdgcn_exp2f(l0 - mx), e1 = __builtin_amdgcn_exp2f(l1 - mx), e2 = __builtin_amdgcn_exp2f(l2 - mx), inv = 1.0f / (e0 + e1 + e2);
            const unsigned a0 = *(const unsigned*)(odil + (size_t)tkn * 384 + hg * 64 + dd), a1 = *(const unsigned*)(odil + (size_t)tkn * 384 + 128 + hg * 64 + dd), a2 = *(const unsigned*)(odil + (size_t)tkn * 384 + 256 + hg * 64 + dd);
            const float y0 = (e0 * bflo(a0) + e1 * bflo(a1) + e2 * bflo(a2)) * inv, y1 = (e0 * bfhi(a0) + e1 * bfhi(a1) + e2 * bfhi(a2)) * inv;
            *(unsigned*)(ydil + (size_t)tkn * 128 + hg * 64 + dd) = cvtpk(y0, y1);
        }
    }
    GRID_BAR();

#ifdef SELFCHECK
    selfcheck_a(P, ws, ctl, (LAS float*)(lds + wave * 16384), gw, NGW, lane);
    grid.sync();
#endif
    if constexpr (PH(4)) {
        LaneGeom geom; { int t_ = threadIdx.x; asm volatile("" : "+v"(t_)); geom.init(t_); }
        SchedP3 S{geom, G, bx, ws};
        EpiP3 E{(const bf16_t*)(ws + WS_GATES), (bf16_t*)(ws + WS_MERGED)};
        pg8::gemm_phase<EpiP3, SchedP3, true>(lds, S, E); if constexpr (NREP(4) == 2) { pg8::gemm_phase<EpiP3, SchedP3, true>(lds, S, E); }
    }
    GRID_BAR();

    if constexpr (PH(5)) {
        LaneGeom geom; { int t_ = threadIdx.x; asm volatile("" : "+v"(t_)); geom.init(t_); }
        SchedP4 S{geom, G, bx, ws};
        EpiP4 E{P.x, (float*)(ws + WS_X1F)};
        pg8::gemm_phase<EpiP4, SchedP4, true>(lds, S, E); if constexpr (NREP(5) == 2) { pg8::gemm_phase<EpiP4, SchedP4, true>(lds, S, E); }
    }
    GRID_BAR();

#ifdef SELFCHECK
    selfcheck_b(P, ws, ctl, gw, NGW, lane);
    grid.sync();
#endif
    LANE_REFRESH();
    if constexpr (PH(6)) {
        for (int rep_ = 0; rep_ < NREP(6); ++rep_) {
        float* x1f = (float*)(ws + WS_X1F); bf16_t* x1b = rep_ == 0 ? (bf16_t*)(ws + WS_X1B) : (bf16_t*)(ws + WS_QKV); float* x1o = rep_ == 0 ? x1f : (float*)(ws + WS_GATES);
        for (int row = gw; row < NTOK; row += NGW) {
            f32x4* xr = (f32x4*)(x1f + (size_t)row * DM) + lane; f32x4* xo = (f32x4*)(x1o + (size_t)row * DM) + lane;
            f32x4 v[4]; float s = 0.f;
#pragma unroll
            for (int j = 0; j < 4; ++j) { v[j] = xr[64 * j]; s += (v[j][0] + v[j][1]) + (v[j][2] + v[j][3]); }
            const float mean = wave_sum(s) * (1.f / DM); float s2 = 0.f;
#pragma unroll
            for (int j = 0; j < 4; ++j) { v[j] = v[j] - mean; s2 += (v[j][0] * v[j][0] + v[j][1] * v[j][1]) + (v[j][2] * v[j][2] + v[j][3] * v[j][3]); }
            const float rstd = __builtin_amdgcn_rsqf(wave_sum(s2) * (1.f / DM) + LN_EPS);
#pragma unroll
            for (int j = 0; j < 4; ++j) {
                const f32x4 gg = *((const f32x4*)P.ln1_g + lane + 64 * j), bb = *((const f32x4*)P.ln1_b + lane + 64 * j);
                const f32x4 y = v[j] * rstd * gg + bb;
                xo[64 * j] = y;
                u32x2 w; w.x = cvtpk(y[0], y[1]); w.y = cvtpk(y[2], y[3]);
                *((u32x2*)(x1b + (size_t)row * DM) + lane + 64 * j) = w;
            }
        }
        }
    }
    GRID_BAR();

    if constexpr (PH(7)) {
        LaneGeom geom; { int t_ = threadIdx.x; asm volatile("" : "+v"(t_)); geom.init(t_); }
        SchedP6 S{geom, G, bx, ws};
        EpiP6 E{(float*)(ws + WS_SCORES), (bf16_t*)(ws + WS_HIDS)};
        pg8::gemm_phase<EpiP6, SchedP6, true>(lds, S, E); if constexpr (NREP(7) == 2) { pg8::gemm_phase<EpiP6, SchedP6, true>(lds, S, E); }
    }
    GRID_BAR();

    LANE_REFRESH();
    if constexpr (PH(8)) {
        const float* scores = (const float*)(ws + WS_SCORES);
        int* eidx = (int*)(ws + WS_EIDX); float* gwt = (float*)(ws + WS_GWT); int* pos = (int*)(ws + WS_POS);
        const int j = lane & 7, lbase = lane & 56;
        f32x4 rb[8];
#pragma unroll
        for (int q = 0; q < 8; ++q) rb[q] = *((const f32x4*)(P.router_bias + 32 * j) + q);
        for (int t0 = gw * 8; t0 < NTOK; t0 += NGW * 8) {
            const int tkn = t0 + (lane >> 3);
            f32x4 sc[8];
#pragma unroll
            for (int q = 0; q < 8; ++q) sc[q] = *((const f32x4*)(scores + (size_t)tkn * 256 + 32 * j) + q);
            float m1 = NEG_INF, m2 = NEG_INF;
#pragma unroll
            for (int q = 0; q < 8; ++q)
#pragma unroll
                for (int e = 0; e < 4; ++e) { const float v = sc[q][e] + rb[q][e]; m2 = __builtin_fmaxf(m2, __builtin_fminf(m1, v)); m1 = __builtin_fmaxf(m1, v); }
            const float gs = m1 + m2; int rank = 0;
#pragma unroll
            for (int jj = 0; jj < 8; ++jj) { const float og = __shfl(gs, lbase + jj); rank += (og > gs || (og == gs && jj < j)) ? 1 : 0; }
            unsigned removed = rank < 4 ? 0u : 0xffffffffu;
            int my_e = 0; float my_s = 0.f;
#pragma unroll 1
            for (int k = 0; k < TOPK; ++k) {
                float bv = NEG_INF, bs = 0.f; int bi = 32 * j;
#pragma unroll
                for (int q = 0; q < 8; ++q)
#pragma unroll
                    for (int e = 0; e < 4; ++e) { const int i = 4 * q + e; const float v = ((removed >> i) & 1u) ? NEG_INF : sc[q][e] + rb[q][e]; if (v > bv) { bv = v; bs = sc[q][e]; bi = 32 * j + i; } }
#pragma unroll
                for (int o = 1; o < 8; o <<= 1) { const float ov = __shfl_xor(bv, o), os = __shfl_xor(bs, o); const int oi = __shfl_xor(bi, o); if (ov > bv || (ov == bv && oi < bi)) { bv = ov; bs = os; bi = oi; } }
                if (j == k) { my_e = bi; my_s = bs; }
                if ((bi >> 5) == j) removed |= 1u << (bi & 31);
            }
            float ssum = my_s;
#pragma unroll
            for (int o = 1; o < 8; o <<= 1) ssum += __shfl_xor(ssum, o);
            const unsigned r = atomicAdd(ctl + CW_COUNT + my_e, 1u);
            eidx[(size_t)tkn * 8 + j] = my_e; gwt[(size_t)tkn * 8 + j] = my_s / ssum * 2.5f; pos[(size_t)tkn * 8 + j] = (int)r;
        }
    }
    GRID_BAR();

    LANE_REFRESH();
    if constexpr (PH(9)) {
        LAS int* pad_start = (LAS int*)(lds + MISC_OFF + 64);
        LAS int* cstart = pad_start + 260;
        LAS int* cnt_s = cstart + 260;
        if (wave == 0) {
            int c4[4], p4[4]; int csum = 0, psum = 0;
#pragma unroll
            for (int i = 0; i < 4; ++i) { c4[i] = (int)ctl[CW_COUNT + 4 * lane + i]; p4[i] = (c4[i] + 255) & ~255; csum += c4[i]; psum += p4[i]; }
            int cin = csum, pin = psum;
#pragma unroll
            for (int o = 1; o < 64; o <<= 1) { const int a = __shfl_up(cin, o), b = __shfl_up(pin, o); if (lane >= o) { cin += a; pin += b; } }
            int ce = cin - csum, pe = pin - psum;
#pragma unroll
            for (int i = 0; i < 4; ++i) { cstart[4 * lane + i] = ce; pad_start[4 * lane + i] = pe; cnt_s[4 * lane + i] = c4[i]; ce += c4[i]; pe += p4[i]; }
            if (lane == 63) { cstart[256] = ce; pad_start[256] = pe; }
        }
        __syncthreads();
        if (bx == 0) {
            if (tid < 256) { const int t0 = pad_start[tid] >> 8, t1 = pad_start[tid + 1] >> 8;
                for (int t = t0; t < t1; ++t) { const int done = 256 * (t - t0); ctl[CW_TILEE + t] = (unsigned)tid; ctl[CW_TILECB + t] = (unsigned)(cstart[tid] + done); const int left = cnt_s[tid] - done; ctl[CW_TILENV + t] = (unsigned)(left < 256 ? left : 256); } }
            if (tid == 0) ctl[CW_RT] = (unsigned)(pad_start[256] >> 8);
        }
        const int* eidx = (const int*)(ws + WS_EIDX); const float* gwt = (const float*)(ws + WS_GWT); int* pos = (int*)(ws + WS_POS);
        int* row_tok = (int*)(ws + WS_ROWTOK); float* row_w = (float*)(ws + WS_ROWW);
        for (int a = gtid; a < NASSIGN; a += NTHR) {
            const int e = eidx[a], r = pos[a]; const int d = pad_start[e] + r, cc = cstart[e] + r;
            row_tok[d] = a >> 3; row_w[d] = gwt[a]; pos[a] = cc;
        }
        for (int i = gtid; i < NEXP * 256; i += NTHR) {
            const int e = i >> 8, jj = cnt_s[e] + (i & 255);
            if (jj < pad_start[e + 1] - pad_start[e]) { const int d = pad_start[e] + jj; row_tok[d] = 0; row_w[d] = 0.f; }
        }
    }
    GRID_BAR();

    const int RT = (int)__builtin_amdgcn_readfirstlane(((volatile unsigned*)ctl)[CW_RT]);
    LANE_REFRESH();
    LAS unsigned short* l_tile_e = (LAS unsigned short*)(lds + MISC_OFF + 64);
    LAS unsigned short* l_tile_nv = l_tile_e + 1280;
    LAS int* l_tile_cb = (LAS int*)(l_tile_nv + 1280);
    for (int t = tid; t < RT; t += NTHREADS) { l_tile_e[t] = (unsigned short)ctl[CW_TILEE + t]; l_tile_nv[t] = (unsigned short)ctl[CW_TILENV + t]; l_tile_cb[t] = (int)ctl[CW_TILECB + t]; }
    __syncthreads();
    if constexpr (PH(10)) {
        LaneGeom geom; { int t_ = threadIdx.x; asm volatile("" : "+v"(t_)); geom.init(t_); }
        SchedP9 S{geom, G, bx, ws, 2 * RT, l_tile_e};
        EpiP9 E{(bf16_t*)(ws + WS_HID), (const float*)(ws + WS_ROWW)};
        pg8::gemm_phase<EpiP9, SchedP9, true>(lds, S, E); if constexpr (NREP(10) == 2) { pg8::gemm_phase<EpiP9, SchedP9, true>(lds, S, E); }
    }
    GRID_BAR();

    if constexpr (PH(11)) {
        LaneGeom geom; { int t_ = threadIdx.x; asm volatile("" : "+v"(t_)); geom.init(t_); }
        SchedP10 S{geom, G, bx, ws, 4 * RT, l_tile_e, l_tile_nv, l_tile_cb};
        EpiP10 E{ws};
        pg8::gemm_phase<EpiP10, SchedP10, true>(lds, S, E); if constexpr (NREP(11) == 2) { pg8::gemm_phase<EpiP10, SchedP10, true>(lds, S, E); }
        SchedP10s S2{geom, G, bx, ws, (4 * RT) % G};
        if constexpr (NREP(13) == 2) { EpiP10s E3{(float*)(ws + WS_X1F), (float*)(ws + WS_XB)}; pg8::gemm_phase<EpiP10s, SchedP10s, true>(lds, S2, E3); }
        EpiP10s E2{(float*)(ws + WS_X1F), (float*)(ws + WS_X1F)};
        pg8::gemm_phase<EpiP10s, SchedP10s, true>(lds, S2, E2);
    }
    GRID_BAR();

    LANE_REFRESH();
    if constexpr (PH(12)) {
        const float* x1f = (const float*)(ws + WS_X1F); const int* pos = (const int*)(ws + WS_POS);
        for (int rep_ = 0; rep_ < NREP(12); ++rep_)
        for (int row = gw; row < NTOK; row += NGW) {
            const f32x4* xr = (const f32x4*)(x1f + (size_t)row * DM + 16 * lane);
            f32x4 v[4], ys[4];
#pragma unroll
            for (int j = 0; j < 4; ++j) { v[j] = xr[j]; ys[j] = (f32x4){0.f, 0.f, 0.f, 0.f}; }
            u32x4 yw[TOPK];
#pragma unroll
            for (int k = 0; k < TOPK; ++k) { const int yr = __builtin_amdgcn_readfirstlane(pos[(size_t)row * 8 + k]); yw[k] = *(const u32x4*)(ws + WS_Y + (size_t)yr * DM + 16 * lane); }
#pragma unroll
            for (int k = 0; k < TOPK; ++k)
#pragma unroll
                for (int j = 0; j < 4; ++j) { const unsigned w = yw[k][j]; const f32x2 lo = __builtin_amdgcn_cvt_pk_f32_fp8(w, false), hi2 = __builtin_amdgcn_cvt_pk_f32_fp8(w, true); ys[j][0] += lo[0]; ys[j][1] += lo[1]; ys[j][2] += hi2[0]; ys[j][3] += hi2[1]; }
            float s = 0.f;
#pragma unroll
            for (int j = 0; j < 4; ++j) { v[j] = v[j] + ys[j] * (1.0f / Y_SCALE); s += (v[j][0] + v[j][1]) + (v[j][2] + v[j][3]); }
            const float mean = wave_sum(s) * (1.f / DM); float s2 = 0.f;
#pragma unroll
            for (int j = 0; j < 4; ++j) { v[j] = v[j] - mean; s2 += (v[j][0] * v[j][0] + v[j][1] * v[j][1]) + (v[j][2] * v[j][2] + v[j][3] * v[j][3]); }
            const float rstd = __builtin_amdgcn_rsqf(wave_sum(s2) * (1.f / DM) + LN_EPS);
            f32x4* orow = (f32x4*)(P.out + (size_t)row * DM + 16 * lane);
#pragma unroll
            for (int j = 0; j < 4; ++j) { const f32x4 gg = *((const f32x4*)(P.ln2_g + 16 * lane) + j), bb = *((const f32x4*)(P.ln2_b + 16 * lane) + j); orow[j] = v[j] * rstd * gg + bb; }
        }
#ifdef SELFCHECK
        if (gw == 0 && lane == 0) {
            VM_WAIT();
            int first = 0; float frac = 0.f;
            for (int i = 1; i < 10; ++i) { const unsigned bad = ((volatile unsigned*)ctl)[CW_CHK + i], tot = ((volatile unsigned*)ctl)[CW_CHK + 16 + i]; if (first == 0 && (bad > 0u || tot != 2048u)) { first = i; frac = tot == 2048u ? (float)bad / 2048.f : 1.f; } }
            if (first > 0) P.out[0] = sqrtf(33554432.f * (3.f * (float)first + 2.f * frac));
        }
#endif
    }
}

extern "C" void kernel_launch(void* const* d_in, const int* in_sizes, int n_in, void* d_out, int out_size, void* d_ws, size_t ws_size, hipStream_t stream) {
    static int grid = 0;
    if (grid == 0) {
        if (n_in != 23 || out_size != NTOK * DM || ws_size < WS_END) { fprintf(stderr, "kernel_launch: unexpected shapes (n_in %d, out %d, ws %zu)\n", n_in, out_size, ws_size); grid = -1; return; }
        int dev = 0, cus = 0, per_cu = 0;
        if (hipGetDevice(&dev) != hipSuccess || hipDeviceGetAttribute(&cus, hipDeviceAttributeMultiprocessorCount, dev) != hipSuccess) { grid = -1; return; }
        if (hipFuncSetAttribute((const void*)fwd_megakernel, hipFuncAttributeMaxDynamicSharedMemorySize, LDS_BYTES) != hipSuccess) { fprintf(stderr, "kernel_launch: hipFuncSetAttribute failed\n"); grid = -1; return; }
        if (hipOccupancyMaxActiveBlocksPerMultiprocessor(&per_cu, (const void*)fwd_megakernel, NTHREADS, LDS_BYTES) != hipSuccess || per_cu < 1) { fprintf(stderr, "kernel_launch: occupancy query failed (%d)\n", per_cu); grid = -1; return; }
        grid = cus * 1;
    }
    if (grid < 0) return;
    Params p{};
    p.x = (const float*)d_in[0]; p.mem = (const float*)d_in[1]; p.positions = (const int*)d_in[2];
    p.w_in = (const float*)d_in[3]; p.w_mem_kv = (const float*)d_in[4]; p.w_gate = (const float*)d_in[5]; p.b_gate = (const float*)d_in[6];
    p.w_br_dil = (const float*)d_in[7]; p.w_br_moba = (const float*)d_in[8]; p.w_br_mem = (const float*)d_in[9]; p.w_out = (const float*)d_in[10];
    p.ln1_g = (const float*)d_in[11]; p.ln1_b = (const float*)d_in[12]; p.w_router = (const float*)d_in[13]; p.router_bias = (const float*)d_in[14];
    p.w_e_gate = (const float*)d_in[15]; p.w_e_up = (const float*)d_in[16]; p.w_e_down = (const float*)d_in[17];
    p.w_s_gate = (const float*)d_in[18]; p.w_s_up = (const float*)d_in[19]; p.w_s_down = (const float*)d_in[20]; p.ln2_g = (const float*)d_in[21]; p.ln2_b = (const float*)d_in[22];
    p.out = (float*)d_out; p.ws = (unsigned char*)d_ws;
    void* args[] = {&p};
    hipError_t e = hipLaunchCooperativeKernel((const void*)fwd_megakernel, dim3(grid), dim3(NTHREADS), args, LDS_BYTES, stream);
    if (e != hipSuccess) fprintf(stderr, "kernel_launch: cooperative launch failed: %s (grid %d)\n", hipGetErrorString(e), grid);
}
```
